# Optimizing an MI355X kernel written in HIP

```python
import math
import jax, jax.numpy as jnp
from jax import lax
import numpy as np

D_MODEL = 1024
BATCH = 8
SEQ = 4096
DEPTH = 1

CHUNK = 64
N_META = 16
N_PAD = CHUNK - N_META
EPS = 1e-6

SSD_EXPAND = 2
SSD_D_INNER = SSD_EXPAND * D_MODEL
SSD_HEAD_DIM = 64
SSD_N_HEADS = SSD_D_INNER // SSD_HEAD_DIM
SSD_N_GROUPS = 8
SSD_HEADS_PER_GROUP = SSD_N_HEADS // SSD_N_GROUPS
SSD_D_STATE = 128
SSD_CONV_W = 4
SSD_CONV_DIM = SSD_D_INNER + 2 * SSD_N_GROUPS * SSD_D_STATE

SC_WIDTH = D_MODEL
SC_CONV_W = 3

N_BRANCH = 2

PEER_HEADS = 8
PEER_N_KEYS = 128
PEER_N_EXPERTS = PEER_N_KEYS * PEER_N_KEYS
PEER_D_KEY = 256
PEER_HALF = PEER_D_KEY // 2
PEER_TOPK = 16
PEER_BLOCK = CHUNK

PROJ_SIZES = (
    SSD_D_INNER,
    SSD_D_INNER,
    SSD_N_GROUPS * SSD_D_STATE,
    SSD_N_GROUPS * SSD_D_STATE,
    SSD_N_HEADS,
    SC_WIDTH,
    SC_WIDTH,
    SC_WIDTH,
    N_BRANCH * D_MODEL,
)
PROJ_TOTAL = sum(PROJ_SIZES)

kernel_name = "hybrid_ssd_shortconv_peer_block"


def rmsnorm(x, g):
    xf = x.astype(jnp.float32)
    y = xf * lax.rsqrt(jnp.mean(xf * xf, axis=-1, keepdims=True) + EPS)
    return (y * g).astype(x.dtype)


def group_rmsnorm(y, g, groups):
    shp = y.shape
    yg = y.reshape(shp[:-1] + (groups, shp[-1] // groups)).astype(jnp.float32)
    yg = yg * lax.rsqrt(jnp.mean(yg * yg, axis=-1, keepdims=True) + EPS)
    return yg.reshape(shp) * g


def causal_dwconv(x, w):
    K = w.shape[-1]
    L = x.shape[1]
    xp = jnp.pad(x, ((0, 0), (K - 1, 0), (0, 0)))
    y = xp[:, 0:L, :] * w[:, 0]
    for k in range(1, K):
        y = y + xp[:, k:k + L, :] * w[:, k]
    return y


def ssd_chunked_scan(xdt, adt, bm, cm):
    b, L = xdt.shape[:2]
    nc = L // CHUNK

    def to_chunks(t):
        return jnp.moveaxis(t.reshape((b, nc, CHUNK) + t.shape[2:]), 1, 0)

    causal = jnp.tril(jnp.ones((CHUNK, CHUNK), dtype=bool))[None, :, :, None, None]

    def step(state, inp):
        xc, ac, bc, cc = inp
        acum = jnp.cumsum(ac.astype(jnp.float32), axis=1)
        seg = acum[:, :, None] - acum[:, None, :]
        decay = jnp.exp(jnp.where(causal, seg, -jnp.inf))
        cb = jnp.einsum('blgn,bsgn->blsg', cc, bc).astype(jnp.float32)
        y_diag = jnp.einsum('blsgr,bsgrp->blgrp', cb[..., None] * decay, xc)
        y_off = jnp.einsum('blgn,bgrpn->blgrp', cc, state) * jnp.exp(acum)[..., None]
        to_end = jnp.exp(acum[:, -1:] - acum)
        new_state = (state * jnp.exp(acum[:, -1])[..., None, None]
                     + jnp.einsum('blgn,blgr,blgrp->bgrpn', bc, to_end, xc))
        return new_state, y_diag + y_off

    state0 = jnp.zeros((b, SSD_N_GROUPS, SSD_HEADS_PER_GROUP, SSD_HEAD_DIM, SSD_D_STATE), jnp.float32)
    _, y = lax.scan(step, state0, (to_chunks(xdt), to_chunks(adt), to_chunks(bm), to_chunks(cm)))
    return jnp.moveaxis(y, 0, 1).reshape((b, L) + xdt.shape[2:])


def ssd_branch(z, xs, bs, cs, dt, valid, conv_w, conv_b, dt_bias, a_log, d_skip, norm_g, w_out):
    b, L, _ = xs.shape
    xbc = jnp.concatenate([xs, bs, cs], axis=-1)
    xbc = jax.nn.silu(causal_dwconv(xbc, conv_w) + conv_b) * valid
    xs = xbc[..., :SSD_D_INNER]
    bs = xbc[..., SSD_D_INNER:SSD_D_INNER + SSD_N_GROUPS * SSD_D_STATE]
    cs = xbc[..., SSD_D_INNER + SSD_N_GROUPS * SSD_D_STATE:]
    dt = jax.nn.softplus(dt.astype(jnp.float32) + dt_bias)
    a = -jnp.exp(a_log.astype(jnp.float32))
    xh = xs.reshape(b, L, SSD_N_GROUPS, SSD_HEADS_PER_GROUP, SSD_HEAD_DIM)
    dtg = dt.reshape(b, L, SSD_N_GROUPS, SSD_HEADS_PER_GROUP)
    y = ssd_chunked_scan(xh * dtg[..., None],
                         dtg * a.reshape(SSD_N_GROUPS, SSD_HEADS_PER_GROUP),
                         bs.reshape(b, L, SSD_N_GROUPS, SSD_D_STATE),
                         cs.reshape(b, L, SSD_N_GROUPS, SSD_D_STATE))
    y = y + xh * d_skip.reshape(SSD_N_GROUPS, SSD_HEADS_PER_GROUP)[..., None]
    y = y.reshape(b, L, SSD_D_INNER)
    y = group_rmsnorm(y * jax.nn.silu(z.astype(jnp.float32)), norm_g, SSD_N_GROUPS)
    return y.astype(xs.dtype) @ w_out


def shortconv_branch(sb, sc, sx, conv_w, w_out):
    return (sb * causal_dwconv(sc * sx, conv_w)) @ w_out


def peer_ffn(h, w_q, sub_keys, expert_u, expert_v):
    T, D = h.shape
    blocks = h.reshape(T // PEER_BLOCK, PEER_BLOCK, D)

    def one(xb):
        q = (xb @ w_q).reshape(PEER_BLOCK, PEER_HEADS, 2, PEER_HALF)
        s = jnp.einsum('thjd,hjkd->thjk', q, sub_keys).astype(jnp.float32)
        sv, si = lax.top_k(s, PEER_TOPK)
        cand = sv[:, :, 0, :, None] + sv[:, :, 1, None, :]
        cs, ci = lax.top_k(cand.reshape(PEER_BLOCK, PEER_HEADS, PEER_TOPK * PEER_TOPK), PEER_TOPK)
        i1 = jnp.take_along_axis(si[:, :, 0], ci // PEER_TOPK, axis=-1)
        i2 = jnp.take_along_axis(si[:, :, 1], ci % PEER_TOPK, axis=-1)
        eidx = i1 * PEER_N_KEYS + i2
        g = jax.nn.softmax(cs, axis=-1)
        u = expert_u[eidx]
        v = expert_v[eidx]
        act = jax.nn.gelu(jnp.einsum('td,thkd->thk', xb, u).astype(jnp.float32), approximate=False)
        return jnp.einsum('thk,thkd->td', (g * act).astype(v.dtype), v)

    return lax.map(one, blocks).reshape(T, D)


def setup_inputs(seed: int = 0) -> dict:
    key = jax.random.key(seed)
    ks = jax.random.split(key, 22)
    f32 = jnp.float32

    def nrm(k, shape, scale):
        return jax.random.normal(k, shape, f32) * scale

    x = nrm(ks[0], (BATCH, SEQ, D_MODEL), 1.0)
    meta_tokens = nrm(ks[1], (N_META, D_MODEL), 1.0)
    ln_mix = 1.0 + nrm(ks[2], (DEPTH, D_MODEL), 0.02)
    w_in = nrm(ks[3], (DEPTH, D_MODEL, PROJ_TOTAL), D_MODEL ** -0.5)
    ssd_conv_w = nrm(ks[4], (DEPTH, SSD_CONV_DIM, SSD_CONV_W), SSD_CONV_W ** -0.5)
    ssd_conv_b = nrm(ks[5], (DEPTH, SSD_CONV_DIM), 0.01)
    dt0 = jnp.exp(jax.random.uniform(ks[6], (DEPTH, SSD_N_HEADS), f32, math.log(1e-3), math.log(1e-1)))
    ssd_dt_bias = dt0 + jnp.log(-jnp.expm1(-dt0))
    ssd_a_log = jnp.log(jax.random.uniform(ks[7], (DEPTH, SSD_N_HEADS), f32, 1.0, 16.0))
    ssd_d = 1.0 + nrm(ks[8], (DEPTH, SSD_N_HEADS), 0.02)
    ssd_norm = 1.0 + nrm(ks[9], (DEPTH, SSD_D_INNER), 0.02)
    ssd_w_out = nrm(ks[10], (DEPTH, SSD_D_INNER, D_MODEL), SSD_D_INNER ** -0.5)
    sc_conv_w = nrm(ks[11], (DEPTH, SC_WIDTH, SC_CONV_W), SC_CONV_W ** -0.5)
    sc_w_out = nrm(ks[12], (DEPTH, SC_WIDTH, D_MODEL), SC_WIDTH ** -0.5)
    w_o = nrm(ks[13], (DEPTH, D_MODEL, D_MODEL), D_MODEL ** -0.5)
    ln_ffn = 1.0 + nrm(ks[14], (DEPTH, D_MODEL), 0.02)
    peer_w_q = nrm(ks[15], (DEPTH, D_MODEL, PEER_HEADS * PEER_D_KEY), D_MODEL ** -0.5)
    peer_sub_keys = nrm(ks[16], (DEPTH, PEER_HEADS, 2, PEER_N_KEYS, PEER_HALF), PEER_HALF ** -0.5)
    peer_u = nrm(ks[17], (DEPTH, PEER_N_EXPERTS, D_MODEL), D_MODEL ** -0.5)
    peer_v = nrm(ks[18], (DEPTH, PEER_N_EXPERTS, D_MODEL), PEER_HEADS ** -0.5)
    ln_final = 1.0 + nrm(ks[19], (D_MODEL,), 0.02)
    return {"x": x, "meta_tokens": meta_tokens, "ln_mix": ln_mix, "w_in": w_in,
            "ssd_conv_w": ssd_conv_w, "ssd_conv_b": ssd_conv_b, "ssd_dt_bias": ssd_dt_bias,
            "ssd_a_log": ssd_a_log, "ssd_d": ssd_d, "ssd_norm": ssd_norm, "ssd_w_out": ssd_w_out,
            "sc_conv_w": sc_conv_w, "sc_w_out": sc_w_out, "w_o": w_o, "ln_ffn": ln_ffn,
            "peer_w_q": peer_w_q, "peer_sub_keys": peer_sub_keys, "peer_u": peer_u,
            "peer_v": peer_v, "ln_final": ln_final}


def reference(x, meta_tokens, ln_mix, w_in, ssd_conv_w, ssd_conv_b, ssd_dt_bias, ssd_a_log, ssd_d,
              ssd_norm, ssd_w_out, sc_conv_w, sc_w_out, w_o, ln_ffn, peer_w_q, peer_sub_keys,
              peer_u, peer_v, ln_final):
    b = x.shape[0]
    pad = jnp.zeros((b, N_PAD, D_MODEL), x.dtype)
    meta = jnp.broadcast_to(meta_tokens[None].astype(x.dtype), (b, N_META, D_MODEL))
    h = jnp.concatenate([pad, meta, x], axis=1)
    lp = h.shape[1]
    valid = (jnp.arange(lp) >= N_PAD)[None, :, None].astype(x.dtype)
    split_idx = [int(c) for c in np.cumsum(PROJ_SIZES)[:-1]]

    for l in range(DEPTH):
        u = rmsnorm(h, ln_mix[l]) * valid
        proj = u @ w_in[l]
        z, xs, bs, cs, dt, sb, sc, sx, gates = jnp.split(proj, split_idx, axis=-1)
        y_ssd = ssd_branch(z, xs, bs, cs, dt, valid, ssd_conv_w[l], ssd_conv_b[l], ssd_dt_bias[l],
                           ssd_a_log[l], ssd_d[l], ssd_norm[l], ssd_w_out[l])
        y_sc = shortconv_branch(sb, sc, sx, sc_conv_w[l], sc_w_out[l])
        g = jax.nn.sigmoid(gates.astype(jnp.float32))
        merged = (g[..., :D_MODEL] * y_ssd + g[..., D_MODEL:] * y_sc).astype(x.dtype)
        h = h + merged @ w_o[l]
        u = rmsnorm(h, ln_ffn[l]) * valid
        ff = peer_ffn(u.reshape(-1, D_MODEL), peer_w_q[l], peer_sub_keys[l], peer_u[l], peer_v[l])
        h = h + ff.reshape(h.shape).astype(h.dtype)

    out = rmsnorm(h[:, N_PAD + N_META:], ln_final)
    return out
```

```cpp
#include <hip/hip_runtime.h>
#include <cstdio>
#include <cstdint>
#include <cmath>
namespace pg8 {
#define PG8_LAS __attribute__((address_space(3)))
typedef unsigned short bf16_t;
typedef short bf16x8 __attribute__((ext_vector_type(8)));
typedef float f32x4 __attribute__((ext_vector_type(4)));
typedef unsigned u32x4 __attribute__((ext_vector_type(4)));
constexpr int BM = 256, BK = 64, HALF = 128, HTB = HALF * BK * 2  , STAGE_BYTES = 8 * HTB, NXCD = 8, WGM = 8;

__host__ __device__ __forceinline__ int lds_byte(int r, int c) { const int st = (r >> 4) * 2 + (c >> 5), rr = r & 15, cc = c & 31, ob = rr * 64 + cc * 2; return st * 1024 + (ob ^ (((ob >> 9) & 1) << 5)); }
__host__ __device__ __forceinline__ void stage_rc(int b, int& R, int& C) { const int st = b / 1024, sb = b % 1024, swz = sb ^ (((sb >> 9) & 1) << 5); R = (st >> 1) * 16 + swz / 64; C = (st & 1) * 32 + (swz % 64) / 2; }
__host__ __device__ __forceinline__ int perm32(int rho) { const int n = rho >> 4, i = rho & 15; return 8 * (i >> 2) + 4 * n + (i & 3); }

struct Unit { int pm, pn; };
struct Gemm { const bf16_t* A; const bf16_t* Bt; int M, N, K; };

struct StaticOrder {
    int nM, nN, nwg, G, c;
    __host__ __device__ void init(int M, int N, int G_, int c_) { nM = M / BM; nN = N / BM; nwg = nM * nN; G = G_; c = c_; }
    __host__ __device__ bool next(int i, Unit& u) const {
        const long L = (long)i * G + c; if (L >= nwg) return false;
        int wgid = (int)L; { const int q = nwg / NXCD, r = nwg % NXCD, xcd = wgid % NXCD, off = wgid / NXCD; wgid = (xcd < r ? xcd * (q + 1) : r * (q + 1) + (xcd - r) * q) + off; }
        const int nig = WGM * nN, gid = wgid / nig, fm = gid * WGM, gsz = (nM - fm) < WGM ? (nM - fm) : WGM;
        u.pm = fm + ((wgid % nig) % gsz); u.pn = (wgid % nig) / gsz; return true;
    }
    __device__ __forceinline__ void a_ready(const Unit&) const {}
    __device__ __forceinline__ void done(const Unit&) const {}
};

__device__ __forceinline__ unsigned cvt_pk_bf16(float lo, float hi) { unsigned r; asm volatile("v_cvt_pk_bf16_f32 %0, %1, %2" : "=v"(r) : "v"(lo), "v"(hi)); return r; }
typedef float f32x2 __attribute__((ext_vector_type(2)));
__device__ __forceinline__ float fast_sigmoid(float x) { return __builtin_amdgcn_rcpf(1.0f + __expf(-x)); }
__device__ __forceinline__ float bflo(unsigned u) { return __builtin_bit_cast(float, u << 16); }
__device__ __forceinline__ float bfhi(unsigned u) { return __builtin_bit_cast(float, u & 0xffff0000u); }

struct EpiProj {
    static constexpr bool PERM = true, AFTER_DRAIN = false;
    bf16_t *Zb, *XS, *BMb, *CMb, *SBb, *SCb, *SXb, *GT; float* DT;
    __device__ __forceinline__ void operator()(const f32x4 (&acc)[2][2][4][2], const Unit& u, int wr, int wc, int fr, int fq) const {
        const int row0 = u.pm * BM + wr * 64 + fr; const int pn = u.pn;
        if (pn == 44) {
            if (wc == 0) {
#pragma unroll
                for (int ai = 0; ai < 2; ++ai)
#pragma unroll
                    for (int m = 0; m < 4; ++m) { float* rp = DT + (size_t)(row0 + ai * HALF + m * 16) * 32 + 8 * fq;
                        *(f32x4*)(rp) = acc[ai][0][m][0]; *(f32x4*)(rp + 4) = acc[ai][0][m][1]; }
            }
            return;
        }
        bf16_t* base; int ld, colt;
        if (pn < 8) { base = Zb; ld = 2048; colt = pn * 256; }
        else if (pn < 16) { base = XS; ld = 2048; colt = (pn - 8) * 256; }
        else if (pn < 20) { base = BMb; ld = 1024; colt = (pn - 16) * 256; }
        else if (pn < 24) { base = CMb; ld = 1024; colt = (pn - 20) * 256; }
        else if (pn < 28) { base = SBb; ld = 1024; colt = (pn - 24) * 256; }
        else if (pn < 32) { base = SCb; ld = 1024; colt = (pn - 28) * 256; }
        else if (pn < 36) { base = SXb; ld = 1024; colt = (pn - 32) * 256; }
        else { base = GT; ld = 2048; colt = (pn - 36) * 256; }
        const int col0 = colt + wc * 32 + 8 * fq;
#pragma unroll
        for (int ai = 0; ai < 2; ++ai)
#pragma unroll
            for (int m = 0; m < 4; ++m) { bf16_t* rowp = base + (size_t)(row0 + ai * HALF + m * 16) * ld + col0;
#pragma unroll
                for (int bj = 0; bj < 2; ++bj) { const f32x4 v0 = acc[ai][bj][m][0], v1 = acc[ai][bj][m][1];
                    u32x4 w; w.x = cvt_pk_bf16(v0[0], v0[1]); w.y = cvt_pk_bf16(v0[2], v0[3]); w.z = cvt_pk_bf16(v1[0], v1[1]); w.w = cvt_pk_bf16(v1[2], v1[3]);
                    *(u32x4*)(rowp + bj * HALF) = w; } }
    }
};
struct EpiBf16Plain {
    static constexpr bool PERM = true, AFTER_DRAIN = false;
    bf16_t* O; int ldc;
    __device__ __forceinline__ void operator()(const f32x4 (&acc)[2][2][4][2], const Unit& u, int wr, int wc, int fr, int fq) const {
        const int row0 = u.pm * BM + wr * 64 + fr; const int col0 = u.pn * BM + wc * 32 + 8 * fq;
#pragma unroll
        for (int ai = 0; ai < 2; ++ai)
#pragma unroll
            for (int m = 0; m < 4; ++m) { bf16_t* rowp = O + (size_t)(row0 + ai * HALF + m * 16) * ldc + col0;
#pragma unroll
                for (int bj = 0; bj < 2; ++bj) { const f32x4 v0 = acc[ai][bj][m][0], v1 = acc[ai][bj][m][1];
                    u32x4 w; w.x = cvt_pk_bf16(v0[0], v0[1]); w.y = cvt_pk_bf16(v0[2], v0[3]); w.z = cvt_pk_bf16(v1[0], v1[1]); w.w = cvt_pk_bf16(v1[2], v1[3]);
                    *(u32x4*)(rowp + bj * HALF) = w; } }
    }
};
struct EpiF32Plain {
    static constexpr bool PERM = false, AFTER_DRAIN = false;
    float* C; int ldc;
    __device__ __forceinline__ void operator()(const f32x4 (&acc)[2][2][4][2], const Unit& u, int wr, int wc, int fr, int fq) const {
        const int row0 = u.pm * BM + wr * 64 + fr, col0 = u.pn * BM + wc * 32 + 4 * fq;
#pragma unroll
        for (int ai = 0; ai < 2; ++ai)
#pragma unroll
            for (int m = 0; m < 4; ++m) { float* rowp = C + (size_t)(row0 + ai * HALF + m * 16) * ldc + col0;
#pragma unroll
                for (int bj = 0; bj < 2; ++bj)
#pragma unroll
                    for (int n = 0; n < 2; ++n) *(f32x4*)(rowp + bj * HALF + n * 16) = acc[ai][bj][m][n]; }
    }
};
struct EpiMerge {
    static constexpr bool PERM = false, AFTER_DRAIN = false;
    const float* YS; const bf16_t* GT; bf16_t* O;
    __device__ __forceinline__ void operator()(const f32x4 (&acc)[2][2][4][2], const Unit& u, int wr, int wc, int fr, int fq) const {
        const int row0 = u.pm * BM + wr * 64 + fr, col0 = u.pn * BM + wc * 32 + 4 * fq;
#pragma unroll
        for (int ai = 0; ai < 2; ++ai)
#pragma unroll
            for (int m = 0; m < 4; ++m) { const size_t row = (size_t)(row0 + ai * HALF + m * 16);
#pragma unroll
                for (int bj = 0; bj < 2; ++bj)
#pragma unroll
                    for (int n = 0; n < 2; ++n) { const int col = col0 + bj * HALF + n * 16;
                        const f32x4 ys = *(const f32x4*)(YS + row * 1024 + col);
                        const uint2 g1 = *(const uint2*)(GT + row * 2048 + col), g2 = *(const uint2*)(GT + row * 2048 + 1024 + col);
                        const f32x4 a = acc[ai][bj][m][n];
                        const float o0 = fast_sigmoid(bflo(g1.x)) * ys[0] + fast_sigmoid(bflo(g2.x)) * a[0];
                        const float o1 = fast_sigmoid(bfhi(g1.x)) * ys[1] + fast_sigmoid(bfhi(g2.x)) * a[1];
                        const float o2 = fast_sigmoid(bflo(g1.y)) * ys[2] + fast_sigmoid(bflo(g2.y)) * a[2];
                        const float o3 = fast_sigmoid(bfhi(g1.y)) * ys[3] + fast_sigmoid(bfhi(g2.y)) * a[3];
                        uint2 w; w.x = cvt_pk_bf16(o0, o1); w.y = cvt_pk_bf16(o2, o3);
                        *(uint2*)(O + row * 1024 + col) = w; } }
    }
};
struct EpiWo {
    static constexpr bool PERM = false, AFTER_DRAIN = false;
    const float* X; float* H1; int soff;
    __device__ __forceinline__ void operator()(const f32x4 (&acc)[2][2][4][2], const Unit& u, int wr, int wc, int fr, int fq) const {
        const int row0 = u.pm * BM + wr * 64 + fr, col0 = u.pn * BM + wc * 32 + 4 * fq;
#pragma unroll
        for (int ai = 0; ai < 2; ++ai)
#pragma unroll
            for (int m = 0; m < 4; ++m) { const int r = row0 + ai * HALF + m * 16; const size_t xr = (size_t)((r >> 11) * 4096 + soff + (r & 2047));
                const float* xp = X + xr * 1024 + col0; float* hp = H1 + (size_t)r * 1024 + col0;
#pragma unroll
                for (int bj = 0; bj < 2; ++bj)
#pragma unroll
                    for (int n = 0; n < 2; ++n) *(f32x4*)(hp + bj * HALF + n * 16) = *(const f32x4*)(xp + bj * HALF + n * 16) + acc[ai][bj][m][n]; }
    }
};
template <class Epi, class Sched, bool ALIGN_EPI = false, bool SP2 = false>
__device__ __forceinline__ void gemm_phase(PG8_LAS unsigned char* lds, const Gemm g, const Sched& S, const Epi& E) {
    int tid_ = threadIdx.x; asm volatile("" : "+v"(tid_)); const int tid = tid_, wid = __builtin_amdgcn_readfirstlane(tid >> 6), lane = tid & 63, wr = wid >> 2, wc = wid & 3, fr = lane & 15, fq = lane >> 4;
    const int K = g.K, nt = K / BK;
    unsigned voffA[2], voffB[2];
#pragma unroll
    for (int i = 0; i < 2; ++i) { int R, C; stage_rc(tid * 16 + i * 8192, R, C); const int Rb = Epi::PERM ? ((R & ~31) + perm32(R & 31)) : R;
        voffA[i] = (unsigned)(R * K + C) * 2u; voffB[i] = (unsigned)(Rb * K + C) * 2u; }
    const size_t kstep = (size_t)(BK * 2);
    const size_t hstep = (size_t)HALF * K * 2;
    const size_t tstep = 2 * hstep;
    const unsigned ldsw = (unsigned)wid * 1024u;
    const int aoff = lds_byte(wr * 64 + fr, fq * 8), boff = lds_byte(wc * 32 + fr, fq * 8);
#define PG8_SA(b, h) (((b) * 2 + (h)) * HTB)
#define PG8_SB(b, h) ((4 + (b) * 2 + (h)) * HTB)
#define PG8_STAGE(bufoff, gbase, voff) do { _Pragma("unroll") for (int _i = 0; _i < 2; ++_i) \
        __builtin_amdgcn_global_load_lds((const unsigned*)((const char*)(gbase) + (voff)[_i]), (PG8_LAS unsigned*)(lds + (bufoff) + ldsw + _i * 8192), 16, 0, 0); } while (0)
#define PG8_LDA(dst, b, h) do { _Pragma("unroll") for (int m = 0; m < 4; ++m) _Pragma("unroll") for (int k = 0; k < 2; ++k) dst[m][k] = *(const PG8_LAS bf16x8*)(lds + PG8_SA(b, h) + aoff + m * 2048 + k * 1024); } while (0)
#define PG8_LDB(dst, b, h) do { _Pragma("unroll") for (int n = 0; n < 2; ++n) _Pragma("unroll") for (int k = 0; k < 2; ++k) dst[n][k] = *(const PG8_LAS bf16x8*)(lds + PG8_SB(b, h) + boff + n * 2048 + k * 1024); } while (0)
#define PG8_MMA(ai, bj, At, Bt) do { __builtin_amdgcn_s_setprio(1); _Pragma("unroll") for (int m = 0; m < 4; ++m) _Pragma("unroll") for (int n = 0; n < 2; ++n) _Pragma("unroll") for (int k = 0; k < 2; ++k) \
        acc[ai][bj][m][n] = __builtin_amdgcn_mfma_f32_16x16x32_bf16(Bt[n][k], At[m][k], acc[ai][bj][m][n], 0, 0, 0); __builtin_amdgcn_s_setprio(0); } while (0)
#define PG8_WAIT_V(n) asm volatile("s_waitcnt vmcnt(" #n ")" ::: "memory")
#define PG8_WAIT_L(n) asm volatile("s_waitcnt lgkmcnt(" #n ")" ::: "memory")
#define PG8_BAR __builtin_amdgcn_s_barrier()
#define PG8_SCHED __builtin_amdgcn_sched_barrier(0)
    Unit cur, nxt; int ui = 0;
    if (!S.next(0, cur)) return;
    f32x4 acc[2][2][4][2];
#pragma unroll
    for (int a = 0; a < 2; ++a)
#pragma unroll
        for (int b = 0; b < 2; ++b)
#pragma unroll
            for (int m = 0; m < 4; ++m)
#pragma unroll
                for (int n = 0; n < 2; ++n) acc[a][b][m][n] = (f32x4){0.f, 0.f, 0.f, 0.f};
    bf16x8 At[4][2], B0[2][2], B1[2][2];
    const char* cA = (const char*)g.A + (size_t)cur.pm * tstep; const char* cB = (const char*)g.Bt + (size_t)cur.pn * tstep;
    S.a_ready(cur);
    if constexpr (SP2) {
        PG8_STAGE(PG8_SB(0, 0), cB, voffB); PG8_STAGE(PG8_SB(0, 1), cB + hstep, voffB); PG8_STAGE(PG8_SA(0, 0), cA, voffA); PG8_STAGE(PG8_SA(0, 1), cA + hstep, voffA);
        if (wr == 1) PG8_BAR;
        PG8_WAIT_V(2); PG8_BAR;
        PG8_STAGE(PG8_SB(1, 0), cB + kstep, voffB); PG8_STAGE(PG8_SA(1, 0), cA + kstep, voffA); PG8_STAGE(PG8_SB(1, 1), cB + hstep + kstep, voffB);
        PG8_WAIT_V(6); PG8_BAR;
    } else {
        PG8_STAGE(PG8_SB(0, 0), cB, voffB); PG8_STAGE(PG8_SA(0, 0), cA, voffA); PG8_STAGE(PG8_SB(0, 1), cB + hstep, voffB); PG8_STAGE(PG8_SA(0, 1), cA + hstep, voffA);
        if (wr == 1) PG8_BAR;
        PG8_WAIT_V(4); PG8_BAR;
        PG8_STAGE(PG8_SB(1, 0), cB + kstep, voffB); PG8_STAGE(PG8_SA(1, 0), cA + kstep, voffA); PG8_STAGE(PG8_SB(1, 1), cB + hstep + kstep, voffB);
        PG8_WAIT_V(6); PG8_BAR;
    }
    for (;;) {
        const bool has_next = S.next(ui + 1, nxt);
        const char* nA = has_next ? (const char*)g.A + (size_t)nxt.pm * tstep : cA; const char* nB = has_next ? (const char*)g.Bt + (size_t)nxt.pn * tstep : cB;
        for (int t = 0; t < nt; t += 2) {
            const bool last = (t == nt - 2);
            const char* a1 = cA + (size_t)(t + 1) * kstep;
            const char* a2 = last ? nA : cA + (size_t)(t + 2) * kstep; const char* b2 = last ? nB : cB + (size_t)(t + 2) * kstep;
            const char* a3 = a2 + kstep; const char* b3 = b2 + kstep;
            if (last && has_next) S.a_ready(nxt);
            if constexpr (SP2) {
            PG8_LDB(B0, 0, 0); PG8_LDB(B1, 0, 1); PG8_SCHED; PG8_LDA(At, 0, 0); PG8_STAGE(PG8_SA(1, 1), a1 + hstep, voffA);
            PG8_WAIT_V(8); PG8_WAIT_L(0); PG8_BAR; PG8_MMA(0, 0, At, B0); PG8_MMA(0, 1, At, B1); PG8_BAR; PG8_SCHED;
            PG8_LDA(At, 0, 1); PG8_STAGE(PG8_SB(0, 0), b2, voffB); PG8_STAGE(PG8_SB(0, 1), b2 + hstep, voffB); PG8_STAGE(PG8_SA(0, 0), a2, voffA);
            PG8_WAIT_V(8); PG8_WAIT_L(0); PG8_BAR; PG8_MMA(1, 0, At, B0); PG8_MMA(1, 1, At, B1); PG8_BAR; PG8_SCHED;
            PG8_LDB(B0, 1, 0); PG8_LDB(B1, 1, 1); PG8_SCHED; PG8_LDA(At, 1, 0); PG8_STAGE(PG8_SA(0, 1), a2 + hstep, voffA);
            PG8_WAIT_V(8); PG8_WAIT_L(0); PG8_BAR; PG8_MMA(0, 0, At, B0); PG8_MMA(0, 1, At, B1); PG8_BAR; PG8_SCHED;
            PG8_LDA(At, 1, 1); PG8_STAGE(PG8_SB(1, 0), b3, voffB); PG8_STAGE(PG8_SB(1, 1), b3 + hstep, voffB); PG8_STAGE(PG8_SA(1, 0), a3, voffA);
            PG8_WAIT_V(8); PG8_WAIT_L(0); PG8_BAR; PG8_MMA(1, 0, At, B0); PG8_MMA(1, 1, At, B1); PG8_BAR; PG8_SCHED;
            } else {
            PG8_LDB(B0, 0, 0); PG8_SCHED; PG8_LDA(At, 0, 0); PG8_STAGE(PG8_SA(1, 1), a1 + hstep, voffA);
            PG8_WAIT_L(8); PG8_BAR; PG8_WAIT_L(0); PG8_MMA(0, 0, At, B0); PG8_BAR; PG8_SCHED;
            PG8_LDB(B1, 0, 1); PG8_STAGE(PG8_SB(0, 0), b2, voffB);
            PG8_BAR; PG8_WAIT_L(0); PG8_MMA(0, 1, At, B1); PG8_BAR;
            PG8_LDA(At, 0, 1); PG8_STAGE(PG8_SA(0, 0), a2, voffA);
            PG8_BAR; PG8_WAIT_L(0); PG8_MMA(1, 0, At, B0); PG8_BAR; PG8_SCHED;
            PG8_STAGE(PG8_SB(0, 1), b2 + hstep, voffB);
            PG8_WAIT_V(6); PG8_BAR; PG8_MMA(1, 1, At, B1); PG8_BAR;
            PG8_LDB(B0, 1, 0); PG8_SCHED; PG8_LDA(At, 1, 0); PG8_STAGE(PG8_SA(0, 1), a2 + hstep, voffA);
            PG8_WAIT_L(8); PG8_BAR; PG8_WAIT_L(0); PG8_MMA(0, 0, At, B0); PG8_BAR; PG8_SCHED;
            PG8_LDB(B1, 1, 1); PG8_STAGE(PG8_SB(1, 0), b3, voffB);
            PG8_BAR; PG8_WAIT_L(0); PG8_MMA(0, 1, At, B1); PG8_BAR;
            PG8_LDA(At, 1, 1); PG8_STAGE(PG8_SA(1, 0), a3, voffA);
            PG8_BAR; PG8_WAIT_L(0); PG8_MMA(1, 0, At, B0); PG8_BAR; PG8_SCHED;
            PG8_STAGE(PG8_SB(1, 1), b3 + hstep, voffB);
            PG8_WAIT_V(6); PG8_BAR; PG8_MMA(1, 1, At, B1); PG8_BAR;
            }
        }
        if constexpr (ALIGN_EPI) { if (wr == 0) PG8_BAR; }
        if constexpr (!Epi::AFTER_DRAIN) { E(acc, cur, wr, wc, fr, fq); S.done(cur); }
        if (!has_next) break;
#pragma unroll
        for (int a = 0; a < 2; ++a)
#pragma unroll
            for (int b = 0; b < 2; ++b)
#pragma unroll
                for (int m = 0; m < 4; ++m)
#pragma unroll
                    for (int n = 0; n < 2; ++n) acc[a][b][m][n] = (f32x4){0.f, 0.f, 0.f, 0.f};
        cur = nxt; cA = nA; cB = nB; ++ui;
        if constexpr (ALIGN_EPI) { if (wr == 1) PG8_BAR; }
    }
    PG8_WAIT_V(0);
    if constexpr (!ALIGN_EPI) { if (wr == 0) PG8_BAR; }
    PG8_BAR;
    if constexpr (Epi::AFTER_DRAIN) { E.fused(acc, cur, wr, wc, fr, fq, lds, wid, lane); S.done(cur); }
#undef PG8_SA
#undef PG8_SB
#undef PG8_STAGE
#undef PG8_LDA
#undef PG8_LDB
#undef PG8_MMA
#undef PG8_WAIT_V
#undef PG8_WAIT_L
#undef PG8_BAR
#undef PG8_SCHED
}
}

#define GAS __attribute__((address_space(1)))
#define LAS __attribute__((address_space(3)))
typedef unsigned short bf16;
typedef unsigned v4u __attribute__((ext_vector_type(4)));
typedef unsigned v2u __attribute__((ext_vector_type(2)));
typedef float f32x4 __attribute__((ext_vector_type(4)));
typedef float f32x16 __attribute__((ext_vector_type(16)));
typedef short bf16x8 __attribute__((ext_vector_type(8)));
#define LDS_WAIT() asm volatile("s_waitcnt lgkmcnt(0)" ::: "memory")
#define VM_WAIT() asm volatile("s_waitcnt vmcnt(0)" ::: "memory")

constexpr int NB = 8, SEQ = 4096, DM = 1024, NSLICE = 2, SL = SEQ / NSLICE, RS = NB * SL, RP = RS + 256;
constexpr int NPROJ = 11520;
constexpr float EPS = 1e-6f;
constexpr int NWAVES = 8;
constexpr size_t MiB = 1u << 20;
constexpr size_t WS_CTL = 0, CTL_ZERO_BYTES = 1 * MiB;
constexpr size_t WS_WIN = 1 * MiB;
constexpr size_t WS_WSSD = WS_WIN + 23592960;
constexpr size_t WS_WSC = WS_WSSD + 4 * MiB;
constexpr size_t WS_WO = WS_WSC + 2 * MiB;
constexpr size_t WS_WQ = WS_WO + 2 * MiB;
constexpr size_t WS_SK = WS_WQ + 4 * MiB;
constexpr size_t WS_EU = WS_SK + MiB / 2;
constexpr size_t WS_EV = WS_EU + 32 * MiB;
constexpr size_t WS_STATE = WS_EV + 32 * MiB;
constexpr size_t WS_HALO = WS_STATE + 8 * MiB;
constexpr size_t WS_SCH = WS_HALO + MiB / 2;
constexpr size_t WS_U0 = WS_SCH + MiB / 2;
constexpr size_t SZ_R1 = (size_t)RP * 1024 * 2;
constexpr size_t WS_Z = WS_U0 + SZ_R1;
constexpr size_t WS_XS = WS_Z + 2 * SZ_R1;
constexpr size_t WS_BM = WS_XS + 2 * SZ_R1;
constexpr size_t WS_CM = WS_BM + SZ_R1;
constexpr size_t WS_DT = WS_CM + SZ_R1;
constexpr size_t WS_SB = WS_DT + 5 * MiB / 2;
constexpr size_t WS_SC = WS_SB + SZ_R1;
constexpr size_t WS_SX = WS_SC + SZ_R1;
constexpr size_t WS_GT = WS_SX + SZ_R1;
constexpr size_t WS_END = WS_GT + 2 * SZ_R1;
static_assert(WS_END <= 512 * MiB, "workspace map exceeds 512 MiB");
static_assert((size_t)RP * 32 * 4 <= 5 * MiB / 2, "dt");
constexpr int CW_BAR = 4096;
constexpr int LDS_BYTES = 163840;
constexpr int MISC_OFF = LDS_BYTES - 256;

__device__ __forceinline__ unsigned pk2(float lo, float hi) { unsigned r; asm("v_cvt_pk_bf16_f32 %0, %1, %2" : "=v"(r) : "v"(lo), "v"(hi)); return r; }
__device__ __forceinline__ float bf2f(bf16 v) { return __builtin_bit_cast(float, (unsigned)v << 16); }
__device__ __forceinline__ bf16 f2bf1(float f) { return (bf16)(pk2(f, 0.f) & 0xffffu); }
__device__ __forceinline__ float blo(unsigned u) { return __builtin_bit_cast(float, u << 16); }
__device__ __forceinline__ float bhi(unsigned u) { return __builtin_bit_cast(float, u & 0xffff0000u); }
__device__ __forceinline__ float siluf(float x) { return x * __builtin_amdgcn_rcpf(1.0f + __expf(-x)); }
__device__ __forceinline__ float wave_sum(float v) {
#pragma unroll
    for (int o = 1; o < 64; o <<= 1) v += __shfl_xor(v, o);
    return v;
}
#define XB_TMO      128
#define XB_XCNT(j)  (256  + 64 * (j))
#define XB_XSUB(j)  (1280 + 64 * (j))
#define XB_XGEN(j)  (2304 + 64 * (j))
#define XB_TOP      3328
#define XB_TOPGEN   3392
#define XCD_BAR_WORDS 3456
#define XB_SPIN_CAP (1u << 18)

__device__ __forceinline__ unsigned xb_ld(unsigned* p)              { return __hip_atomic_load(p, __ATOMIC_RELAXED, __HIP_MEMORY_SCOPE_AGENT); }
__device__ __forceinline__ unsigned xb_add(unsigned* p, unsigned v) { return __hip_atomic_fetch_add(p, v, __ATOMIC_RELAXED, __HIP_MEMORY_SCOPE_AGENT); }
__device__ __forceinline__ unsigned xb_xcc_id() { return (unsigned)__builtin_amdgcn_s_getreg((3 << 11) | 20) & 0xFu; }
#define XB_SPIN(cond, bar) do { unsigned _sp = 0; while (cond) { __builtin_amdgcn_s_sleep(1); \
    if ((++_sp & 255u) == 0u) { if (xb_ld(&(bar)[XB_TMO])) break; if (_sp > XB_SPIN_CAP) { atomicAdd(&(bar)[XB_TMO], 1u); break; } } } } while (0)

struct XcdBarrier {
    unsigned* bar; unsigned x;
    volatile LAS unsigned* st;
};

__device__ __forceinline__ XcdBarrier xcd_barrier_post(unsigned* bar, volatile LAS unsigned* st) {
    XcdBarrier b; b.bar = bar; b.x = xb_xcc_id(); b.st = st;
    if (threadIdx.x == 0) (void)xb_add(&bar[XB_XCNT(b.x)], 1u);
    return b;
}
__device__ __forceinline__ void xcd_barrier_complete(unsigned* bar, unsigned x, unsigned& nloc, unsigned& nx) {
    const unsigned G = gridDim.x * gridDim.y * gridDim.z;
    unsigned sum, cnt, mine, sp = 0u;
    for (;;) {
        sum = 0u; cnt = 0u; mine = 0u;
#pragma unroll
        for (unsigned j = 0; j < 16; ++j) { const unsigned c = xb_ld(&bar[XB_XCNT(j)]); sum += c; cnt += (c > 0u) ? 1u : 0u; mine = (j == x) ? c : mine; }
        if (sum == G) break;
        __builtin_amdgcn_s_sleep(1);
        if ((++sp & 255u) == 0u) { if (xb_ld(&bar[XB_TMO])) break; if (sp > XB_SPIN_CAP) { atomicAdd(&bar[XB_TMO], 1u); break; } }
    }
    nloc = mine > 0u ? mine : 1u; nx = cnt > 0u ? cnt : 1u;
}

__device__ __forceinline__ void xcd_barrier(const XcdBarrier& b) {
    asm volatile("s_waitcnt vmcnt(0)" ::: "memory");
    __syncthreads();
    if (threadIdx.x == 0) {
        unsigned* bar = b.bar;
        __builtin_amdgcn_s_waitcnt(0);
        unsigned nloc = b.st[0], nx = b.st[1];
        if (nloc == 0u) { xcd_barrier_complete(bar, b.x, nloc, nx); b.st[0] = nloc; b.st[1] = nx; }
        const unsigned old = xb_add(&bar[XB_XSUB(b.x)], 1u);
        const unsigned gen = old / nloc;
        if (old + 1u == (gen + 1u) * nloc) {
            __builtin_amdgcn_fence(__ATOMIC_RELEASE, "agent");
            asm volatile("s_waitcnt vmcnt(0)" ::: "memory");
            const unsigned og = xb_add(&bar[XB_TOP], 1u);
            const unsigned tg = og / nx;
            if (og + 1u == (tg + 1u) * nx) xb_add(&bar[XB_TOPGEN], 1u);
            else XB_SPIN(xb_ld(&bar[XB_TOPGEN]) == tg, bar);
            __builtin_amdgcn_fence(__ATOMIC_ACQUIRE, "agent");
            xb_add(&bar[XB_XGEN(b.x)], 1u);
            asm volatile("s_waitcnt vmcnt(0)" ::: "memory");
        } else {
            XB_SPIN(xb_ld(&bar[XB_XGEN(b.x)]) == gen, bar);
            __builtin_amdgcn_fence(__ATOMIC_ACQUIRE, "agent");
            asm volatile("s_waitcnt vmcnt(0)" ::: "memory");
        }
    }
    __syncthreads();
}


struct Ctx {
    LAS unsigned char* lds;
    int tid, lane, wave, vcu, G;
    float* out;
    unsigned char* ws;
};
struct Args { const float* in[20]; float* out; unsigned char* ws; int ph_lo, ph_hi; };
static_assert(sizeof(Args) == 22 * 8 + 8, "Args has no padding");
__device__ __forceinline__ int opq(int v) { asm volatile("" : "+v"(v)); return v; }
__device__ __forceinline__ unsigned char* opq_p(unsigned char* p) { asm volatile("" : "+s"(p)); return p; }
enum { I_X = 0, I_META, I_LNMIX, I_WIN, I_CONVW, I_CONVB, I_DTB, I_ALOG, I_D, I_NORM, I_WSSD, I_SCCW, I_WSC, I_WO, I_LNFFN, I_WQ, I_SK, I_PU, I_PV, I_LNF };

__device__ __forceinline__ void tr_item(const float* W, int ldw, int src0, int k0, bf16* WT, int K, int n0, LAS float* scr, int lane) {
#pragma unroll 8
    for (int i = 0; i < 32; ++i) { const int kk = 2 * i + (lane >> 5); scr[kk * 33 + (lane & 31)] = (src0 >= 0) ? W[(size_t)(k0 + kk) * ldw + src0 + (lane & 31)] : 0.f; }
    LDS_WAIT(); asm volatile("" ::: "memory");
    const int c = lane & 7;
#pragma unroll
    for (int j = 0; j < 4; ++j) { const int n = (lane >> 3) + 8 * j; const LAS float* s = scr + (8 * c) * 33 + n;
        v4u o; o.x = pk2(s[0 * 33], s[1 * 33]); o.y = pk2(s[2 * 33], s[3 * 33]); o.z = pk2(s[4 * 33], s[5 * 33]); o.w = pk2(s[6 * 33], s[7 * 33]);
        *(v4u*)(WT + (size_t)(n0 + n) * K + k0 + 8 * c) = o; }
    LDS_WAIT(); asm volatile("" ::: "memory");
}
__device__ __forceinline__ void cvt_item(const float* src, bf16* dst, int lane) {
#pragma unroll
    for (int i = 0; i < 8; ++i) { const f32x4 a = *(const f32x4*)(src + i * 512 + lane * 8), b = *(const f32x4*)(src + i * 512 + lane * 8 + 4);
        v4u o; o.x = pk2(a[0], a[1]); o.y = pk2(a[2], a[3]); o.z = pk2(b[0], b[1]); o.w = pk2(b[2], b[3]);
        *(v4u*)(dst + i * 512 + lane * 8) = o; }
}
__device__ __forceinline__ void rms_row_bf16(const float* xrow, const float* g, bf16* orow, int lane) {
    uint2* o8 = (uint2*)orow + lane;
    if (xrow == nullptr) {
#pragma unroll
        for (int j = 0; j < 4; ++j) o8[64 * j] = make_uint2(0u, 0u);
        return;
    }
    const f32x4* xr = (const f32x4*)xrow + lane; const f32x4* gr = (const f32x4*)g + lane;
    f32x4 v[4]; float s = 0.f;
#pragma unroll
    for (int j = 0; j < 4; ++j) { v[j] = xr[64 * j]; s += (v[j][0] * v[j][0] + v[j][1] * v[j][1]) + (v[j][2] * v[j][2] + v[j][3] * v[j][3]); }
    const float r = rsqrtf(wave_sum(s) * (1.f / 1024.f) + EPS);
#pragma unroll
    for (int j = 0; j < 4; ++j) { const f32x4 gg = gr[64 * j]; o8[64 * j] = make_uint2(pk2(v[j][0] * r * gg[0], v[j][1] * r * gg[1]), pk2(v[j][2] * r * gg[2], v[j][3] * r * gg[3])); }
}
__device__ __forceinline__ const float* u0_src(const Args& A, int sl, int r) {
    if (r < RS) return A.in[I_X] + ((size_t)(r >> 11) * SEQ + sl * SL + (r & (SL - 1))) * DM;
    const int l = r - RS;
    if (l >= 48 && l < 64) return A.in[I_META] + (size_t)(l - 48) * DM;
    return nullptr;
}
__device__ __forceinline__ void phase_prep(Ctx& C, const Args& A) {
    LAS float* scr = (LAS float*)(C.lds + C.wave * 16384);
    const int lane = opq(C.tid) & 63;
    const int gw = C.vcu * NWAVES + C.wave, NGW = C.G * NWAVES;
    unsigned char* ws = opq_p(C.ws);
    constexpr int N_WIN = 16 * 360, N_SSD = 32 * 32, N_SC = 16 * 32, N_WO = 16 * 32, N_WQ = 16 * 64, N_SKC = 64, N_EC = 4096, N_U0 = RP;
    constexpr int NITEMS = N_WIN + N_SSD + N_SC + N_WO + N_WQ + N_SKC + 2 * N_EC + N_U0;
    for (int it = gw; it < NITEMS; it += NGW) {
        int r = it;
        if (r < N_WIN) { const int kb = r / 360, nb = r % 360, n0 = nb * 32;
            const int src0 = (n0 < 6144) ? n0 : (n0 < 11264 ? n0 + 32 : (n0 < 11296 ? n0 - 11264 + 6144 : -1));
            tr_item(A.in[I_WIN], 11296, src0, kb * 64, (bf16*)(ws + WS_WIN), 1024, n0, scr, lane); continue; } r -= N_WIN;
        if (r < N_SSD) { const int kb = r / 32, nb = r % 32; tr_item(A.in[I_WSSD], 1024, nb * 32, kb * 64, (bf16*)(ws + WS_WSSD), 2048, nb * 32, scr, lane); continue; } r -= N_SSD;
        if (r < N_SC) { const int kb = r / 32, nb = r % 32; tr_item(A.in[I_WSC], 1024, nb * 32, kb * 64, (bf16*)(ws + WS_WSC), 1024, nb * 32, scr, lane); continue; } r -= N_SC;
        if (r < N_WO) { const int kb = r / 32, nb = r % 32; tr_item(A.in[I_WO], 1024, nb * 32, kb * 64, (bf16*)(ws + WS_WO), 1024, nb * 32, scr, lane); continue; } r -= N_WO;
        if (r < N_WQ) { const int kb = r / 64, nb = r % 64; tr_item(A.in[I_WQ], 2048, nb * 32, kb * 64, (bf16*)(ws + WS_WQ), 1024, nb * 32, scr, lane); continue; } r -= N_WQ;
        if (r < N_SKC) { cvt_item(A.in[I_SK] + (size_t)r * 4096, (bf16*)(ws + WS_SK) + (size_t)r * 4096, lane); continue; } r -= N_SKC;
        if (r < N_EC) { cvt_item(A.in[I_PU] + (size_t)r * 4096, (bf16*)(ws + WS_EU) + (size_t)r * 4096, lane); continue; } r -= N_EC;
        if (r < N_EC) { cvt_item(A.in[I_PV] + (size_t)r * 4096, (bf16*)(ws + WS_EV) + (size_t)r * 4096, lane); continue; } r -= N_EC;
        rms_row_bf16(u0_src(A, 0, r), A.in[I_LNMIX], (bf16*)(ws + WS_U0) + (size_t)r * DM, lane);
    }
}

constexpr int SC_RAWS = 328;
constexpr int SC_RAW = 0, SC_M = 44032, SC_CC = 53248, SC_BC = 70656, SC_BCT = 88064, SC_XST = 106496, SC_XDTT = 115712, SC_XDTET = 124928, SC_STB = 134144, SC_ACUM = 151552, SC_DTV = 152064;
constexpr int SC_S64 = 72, SC_S128 = 136;
static_assert(SC_DTV + 512 <= MISC_OFF, "scan LDS map");

__device__ __forceinline__ void phase_scan(Ctx& C, const Args& A, int sl) {
    const int tid = opq(C.tid), lane = tid & 63, wave = C.wave, fr = lane & 15, fq = lane >> 4;
    const int bh = C.vcu, b = bh >> 5, h = bh & 31, g = h >> 2;
    unsigned char* ws = opq_p(C.ws);
    bf16* XS = (bf16*)(ws + WS_XS); const bf16* BMp = (const bf16*)(ws + WS_BM); const bf16* CMp = (const bf16*)(ws + WS_CM); const float* DTp = (const float*)(ws + WS_DT);
    LAS bf16* RAW = (LAS bf16*)(C.lds + SC_RAW); LAS bf16* Mm = (LAS bf16*)(C.lds + SC_M); LAS bf16* CC = (LAS bf16*)(C.lds + SC_CC); LAS bf16* BC = (LAS bf16*)(C.lds + SC_BC);
    LAS bf16* BCT = (LAS bf16*)(C.lds + SC_BCT); LAS bf16* XST = (LAS bf16*)(C.lds + SC_XST); LAS bf16* XDTT = (LAS bf16*)(C.lds + SC_XDTT); LAS bf16* XDTET = (LAS bf16*)(C.lds + SC_XDTET);
    LAS bf16* STB = (LAS bf16*)(C.lds + SC_STB); LAS float* ACUM = (LAS float*)(C.lds + SC_ACUM); LAS float* DTV = (LAS float*)(C.lds + SC_DTV);
    const int chx = tid & 63, rbx = tid >> 6, chb = tid & 127, rbb = tid >> 7;
    const float* cw = A.in[I_CONVW]; const float* cb_ = A.in[I_CONVB];
    float wx[4], wB[4], wC[4];
    { const f32x4 t = *(const f32x4*)(cw + (size_t)(h * 64 + chx) * 4); wx[0] = t[0]; wx[1] = t[1]; wx[2] = t[2]; wx[3] = t[3]; }
    { const f32x4 t = *(const f32x4*)(cw + (size_t)(2048 + g * 128 + chb) * 4); wB[0] = t[0]; wB[1] = t[1]; wB[2] = t[2]; wB[3] = t[3]; }
    { const f32x4 t = *(const f32x4*)(cw + (size_t)(3072 + g * 128 + chb) * 4); wC[0] = t[0]; wC[1] = t[1]; wC[2] = t[2]; wC[3] = t[3]; }
    const float bx = cb_[h * 64 + chx], bB = cb_[2048 + g * 128 + chb], bC = cb_[3072 + g * 128 + chb];
    const float dtb = A.in[I_DTB][h], aneg = -__expf(A.in[I_ALOG][h]), dsk = A.in[I_D][h];
    const int tr = wave & 3, tc0 = (wave >> 2) * 2;
    const int tp = wave & 3, tn0 = (wave >> 2) * 4;
    f32x4 st[4];
    float* STATE = (float*)(ws + WS_STATE) + (size_t)bh * 64 * 128;
    bf16* HALO = (bf16*)(ws + WS_HALO) + (size_t)bh * 3 * 320;
    if (sl == 0) {
#pragma unroll
        for (int j = 0; j < 4; ++j) st[j] = (f32x4){0.f, 0.f, 0.f, 0.f};
        for (int i = tid; i < 3 * SC_RAWS; i += 512) RAW[i] = 0;
    } else {
#pragma unroll
        for (int j = 0; j < 4; ++j)
#pragma unroll
            for (int i = 0; i < 4; ++i) st[j][i] = STATE[(tp * 16 + fq * 4 + i) * 128 + (tn0 + j) * 16 + fr];
        for (int i = tid; i < 3 * 320; i += 512) RAW[(i / 320) * SC_RAWS + (i % 320)] = HALO[i];
    }
#pragma unroll
    for (int j = 0; j < 4; ++j)
#pragma unroll
        for (int i = 0; i < 4; ++i) STB[(tp * 16 + fq * 4 + i) * SC_S128 + (tn0 + j) * 16 + fr] = f2bf1(st[j][i]);
    const int c_begin = (sl == 0) ? -1 : 0;
    v4u pre[5]; float dtn = 0.f;
#define ROW_BASE(ci) ((ci) < 0 ? RS : b * SL + (ci) * 64)
#define SCAN_LOAD(ci) do { const int rb_ = ROW_BASE(ci); \
        _Pragma("unroll") for (int i_ = 0; i_ < 5; ++i_) { const int p_ = tid + 512 * i_, r_ = p_ / 40, pc_ = p_ % 40; const size_t gr_ = (size_t)(rb_ + r_); \
            const bf16* src_ = (pc_ < 8) ? (XS + gr_ * 2048 + h * 64 + pc_ * 8) : (pc_ < 24) ? (BMp + gr_ * 1024 + g * 128 + (pc_ - 8) * 8) : (CMp + gr_ * 1024 + g * 128 + (pc_ - 24) * 8); \
            pre[i_] = *(const v4u*)src_; } \
        if (wave == 0) dtn = DTp[(size_t)(rb_ + lane) * 32 + h]; } while (0)
#define SCAN_STORE_RAW() do { _Pragma("unroll") for (int i_ = 0; i_ < 5; ++i_) { const int p_ = tid + 512 * i_, r_ = p_ / 40, pc_ = p_ % 40; \
            *(LAS v4u*)(RAW + (3 + r_) * SC_RAWS + pc_ * 8) = pre[i_]; } } while (0)
#define SCAN_DT(par) do { if (wave == 0) { const float x_ = dtn + dtb; const float dv_ = (x_ > 20.f) ? x_ : log1pf(__expf(x_)); float a_ = aneg * dv_; \
            _Pragma("unroll") for (int o_ = 1; o_ < 64; o_ <<= 1) { const float t_ = __shfl_up(a_, o_); if (lane >= o_) a_ += t_; } \
            ACUM[(par) * 64 + lane] = a_; DTV[(par) * 64 + lane] = dv_; } } while (0)
    SCAN_LOAD(c_begin);
    SCAN_STORE_RAW();
    SCAN_DT(0);
    __syncthreads();
    int par = 0;
    for (int ci = c_begin; ci < SL / 64; ++ci, par ^= 1) {
        const bool has_next = (ci + 1 < SL / 64);
        const int lmask = (ci < 0) ? 48 : 0;
        const LAS float* AC = ACUM + par * 64; const LAS float* DV = DTV + par * 64;
        const float aend = AC[63];
        {
            float r[11];
#pragma unroll
            for (int i = 0; i < 11; ++i) r[i] = bf2f(RAW[(rbx * 8 + i) * SC_RAWS + chx]);
            float xv[8], xd[8], xe[8];
#pragma unroll
            for (int j = 0; j < 8; ++j) { const int l = rbx * 8 + j; float a = bx + wx[0] * r[j] + wx[1] * r[j + 1] + wx[2] * r[j + 2] + wx[3] * r[j + 3];
                a = (l >= lmask) ? siluf(a) : 0.f; xv[j] = a; xd[j] = a * DV[l]; xe[j] = xd[j] * __expf(aend - AC[l]); }
            v4u o;
            o.x = pk2(xv[0], xv[1]); o.y = pk2(xv[2], xv[3]); o.z = pk2(xv[4], xv[5]); o.w = pk2(xv[6], xv[7]); *(LAS v4u*)(XST + chx * SC_S64 + rbx * 8) = o;
            o.x = pk2(xd[0], xd[1]); o.y = pk2(xd[2], xd[3]); o.z = pk2(xd[4], xd[5]); o.w = pk2(xd[6], xd[7]); *(LAS v4u*)(XDTT + chx * SC_S64 + rbx * 8) = o;
            o.x = pk2(xe[0], xe[1]); o.y = pk2(xe[2], xe[3]); o.z = pk2(xe[4], xe[5]); o.w = pk2(xe[6], xe[7]); *(LAS v4u*)(XDTET + chx * SC_S64 + rbx * 8) = o;
        }
        __builtin_amdgcn_sched_barrier(0);
        {
            float r[19];
#pragma unroll
            for (int i = 0; i < 19; ++i) r[i] = bf2f(RAW[(rbb * 16 + i) * SC_RAWS + 64 + chb]);
            float v[16];
#pragma unroll
            for (int j = 0; j < 16; ++j) { const int l = rbb * 16 + j; float a = bB + wB[0] * r[j] + wB[1] * r[j + 1] + wB[2] * r[j + 2] + wB[3] * r[j + 3];
                a = (l >= lmask) ? siluf(a) : 0.f; v[j] = a; BC[l * SC_S128 + chb] = f2bf1(a); }
            v4u o;
            o.x = pk2(v[0], v[1]); o.y = pk2(v[2], v[3]); o.z = pk2(v[4], v[5]); o.w = pk2(v[6], v[7]); *(LAS v4u*)(BCT + chb * SC_S64 + rbb * 16) = o;
            o.x = pk2(v[8], v[9]); o.y = pk2(v[10], v[11]); o.z = pk2(v[12], v[13]); o.w = pk2(v[14], v[15]); *(LAS v4u*)(BCT + chb * SC_S64 + rbb * 16 + 8) = o;
        }
        __builtin_amdgcn_sched_barrier(0);
        {
            float r[19];
#pragma unroll
            for (int i = 0; i < 19; ++i) r[i] = bf2f(RAW[(rbb * 16 + i) * SC_RAWS + 192 + chb]);
#pragma unroll
            for (int j = 0; j < 16; ++j) { const int l = rbb * 16 + j; float a = bC + wC[0] * r[j] + wC[1] * r[j + 1] + wC[2] * r[j + 2] + wC[3] * r[j + 3];
                a = (l >= lmask) ? siluf(a) : 0.f; CC[l * SC_S128 + chb] = f2bf1(a); }
        }
        __syncthreads();
        if (has_next) SCAN_LOAD(ci + 1);
        if (tid < 123) { const v4u t = *(LAS v4u*)((LAS unsigned char*)RAW + 64 * SC_RAWS * 2 + tid * 16); *(LAS v4u*)((LAS unsigned char*)RAW + tid * 16) = t; }
        bf16x8 ca[4];
#pragma unroll
        for (int kk = 0; kk < 4; ++kk) ca[kk] = *(LAS bf16x8*)(CC + (tr * 16 + fr) * SC_S128 + kk * 32 + fq * 8);
        f32x4 yacc[2];
#pragma unroll
        for (int t = 0; t < 2; ++t) {
            const int tc = tc0 + t;
            f32x4 a1 = {0.f, 0.f, 0.f, 0.f}, a2 = {0.f, 0.f, 0.f, 0.f};
#pragma unroll
            for (int kk = 0; kk < 4; ++kk) {
                const bf16x8 bb = *(LAS bf16x8*)(BC + (tc * 16 + fr) * SC_S128 + kk * 32 + fq * 8);
                const bf16x8 sb = *(LAS bf16x8*)(STB + (tc * 16 + fr) * SC_S128 + kk * 32 + fq * 8);
                a1 = __builtin_amdgcn_mfma_f32_16x16x32_bf16(ca[kk], bb, a1, 0, 0, 0);
                a2 = __builtin_amdgcn_mfma_f32_16x16x32_bf16(ca[kk], sb, a2, 0, 0, 0);
            }
            const int s = tc * 16 + fr; const float as = AC[s];
#pragma unroll
            for (int i = 0; i < 4; ++i) { const int l = tr * 16 + fq * 4 + i; const float al = AC[l];
                const float mv = (l >= s) ? a1[i] * __expf(al - as) : 0.f;
                Mm[l * SC_S64 + s] = f2bf1(mv);
                yacc[t][i] = a2[i] * __expf(al); }
        }
        {
            const float dec = __expf(aend);
            bf16x8 xa[2];
#pragma unroll
            for (int kk = 0; kk < 2; ++kk) xa[kk] = *(LAS bf16x8*)(XDTET + (tp * 16 + fr) * SC_S64 + kk * 32 + fq * 8);
#pragma unroll
            for (int j = 0; j < 4; ++j) { st[j] = st[j] * dec;
#pragma unroll
                for (int kk = 0; kk < 2; ++kk) { const bf16x8 bb = *(LAS bf16x8*)(BCT + ((tn0 + j) * 16 + fr) * SC_S64 + kk * 32 + fq * 8);
                    st[j] = __builtin_amdgcn_mfma_f32_16x16x32_bf16(xa[kk], bb, st[j], 0, 0, 0); } }
        }
        __syncthreads();
#pragma unroll
        for (int j = 0; j < 4; ++j)
#pragma unroll
            for (int i = 0; i < 4; ++i) STB[(tp * 16 + fq * 4 + i) * SC_S128 + (tn0 + j) * 16 + fr] = f2bf1(st[j][i]);
        {
            bf16x8 ma[2];
#pragma unroll
            for (int kk = 0; kk < 2; ++kk) ma[kk] = *(LAS bf16x8*)(Mm + (tr * 16 + fr) * SC_S64 + kk * 32 + fq * 8);
            const int rb0 = ROW_BASE(ci);
#pragma unroll
            for (int t = 0; t < 2; ++t) { const int p = (tc0 + t) * 16 + fr;
#pragma unroll
                for (int kk = 0; kk < 2; ++kk) { const bf16x8 xb = *(LAS bf16x8*)(XDTT + p * SC_S64 + kk * 32 + fq * 8);
                    yacc[t] = __builtin_amdgcn_mfma_f32_16x16x32_bf16(ma[kk], xb, yacc[t], 0, 0, 0); }
                if (ci >= 0) {
#pragma unroll
                    for (int i = 0; i < 4; ++i) { const int l = tr * 16 + fq * 4 + i; const float yv = yacc[t][i] + dsk * bf2f(XST[p * SC_S64 + l]);
                        XS[(size_t)(rb0 + l) * 2048 + h * 64 + p] = f2bf1(yv); }
                }
            }
        }
        if (has_next) { SCAN_STORE_RAW(); SCAN_DT(par ^ 1); }
        __syncthreads();
    }
    if (sl + 1 < NSLICE) {
#pragma unroll
        for (int j = 0; j < 4; ++j)
#pragma unroll
            for (int i = 0; i < 4; ++i) STATE[(tp * 16 + fq * 4 + i) * 128 + (tn0 + j) * 16 + fr] = st[j][i];
        for (int i = tid; i < 3 * 320; i += 512) HALO[i] = RAW[(i / 320) * SC_RAWS + (i % 320)];
    }
#undef SCAN_LOAD
#undef ROW_BASE
#undef SCAN_STORE_RAW
#undef SCAN_DT
}

__device__ __forceinline__ void phase_elem(Ctx& C, const Args& A, int sl) {
    const int gw = C.vcu * NWAVES + C.wave, lane = opq(C.tid) & 63;
    unsigned char* ws = opq_p(C.ws);
    bf16* XS = (bf16*)(ws + WS_XS); const bf16* Zb = (const bf16*)(ws + WS_Z);
    {
        const float* ng = A.in[I_NORM];
        f32x4 gq[4][2];
#pragma unroll
        for (int j = 0; j < 4; ++j) { gq[j][0] = *(const f32x4*)(ng + 8 * lane + 512 * j); gq[j][1] = *(const f32x4*)(ng + 8 * lane + 512 * j + 4); }
        for (int rr = 0; rr < 8; ++rr) {
            const size_t r = (size_t)gw * 8 + rr;
            v4u yv[4], zv[4];
#pragma unroll
            for (int j = 0; j < 4; ++j) { yv[j] = *(const v4u*)(XS + r * 2048 + 8 * lane + 512 * j); zv[j] = *(const v4u*)(Zb + r * 2048 + 8 * lane + 512 * j); }
#pragma unroll
            for (int j = 0; j < 4; ++j) {
                float v[8];
#pragma unroll
                for (int q = 0; q < 4; ++q) { v[2 * q] = blo(yv[j][q]) * siluf(blo(zv[j][q])); v[2 * q + 1] = bhi(yv[j][q]) * siluf(bhi(zv[j][q])); }
                float ss = 0.f;
#pragma unroll
                for (int q = 0; q < 8; ++q) ss += v[q] * v[q];
#pragma unroll
                for (int o = 1; o < 32; o <<= 1) ss += __shfl_xor(ss, o);
                const float rs = rsqrtf(ss * (1.f / 256.f) + EPS);
                v4u o4; o4.x = pk2(v[0] * rs * gq[j][0][0], v[1] * rs * gq[j][0][1]); o4.y = pk2(v[2] * rs * gq[j][0][2], v[3] * rs * gq[j][0][3]);
                o4.z = pk2(v[4] * rs * gq[j][1][0], v[5] * rs * gq[j][1][1]); o4.w = pk2(v[6] * rs * gq[j][1][2], v[7] * rs * gq[j][1][3]);
                *(v4u*)(XS + r * 2048 + 8 * lane + 512 * j) = o4;
            }
        }
    }
    {
        const bf16* SBp = (const bf16*)(ws + WS_SB); const bf16* SCp = (const bf16*)(ws + WS_SC); const bf16* SXp = (const bf16*)(ws + WS_SX);
        bf16* SCV = (bf16*)(ws + WS_U0); float* SCH = (float*)(ws + WS_SCH);
        const float* w3 = A.in[I_SCCW];
        const int r0 = gw * 8, b = r0 >> 11, s0 = r0 & (SL - 1);
#pragma unroll
        for (int j = 0; j < 2; ++j) {
            const int ch0 = 8 * lane + 512 * j;
            float w0[8], w1[8], w2[8];
#pragma unroll
            for (int q = 0; q < 8; ++q) { w0[q] = w3[(ch0 + q) * 3 + 0]; w1[q] = w3[(ch0 + q) * 3 + 1]; w2[q] = w3[(ch0 + q) * 3 + 2]; }
            float pm2[8], pm1[8];
            if (s0 == 0 && sl > 0) {
#pragma unroll
                for (int q = 0; q < 8; ++q) { pm2[q] = SCH[(b * 2 + 0) * 1024 + ch0 + q]; pm1[q] = SCH[(b * 2 + 1) * 1024 + ch0 + q]; }
            } else {
                const size_t ra = (s0 == 0) ? (size_t)(RS + 62) : (size_t)(r0 - 2), rb = (s0 == 0) ? (size_t)(RS + 63) : (size_t)(r0 - 1);
                const v4u c2 = *(const v4u*)(SCp + ra * 1024 + ch0), x2 = *(const v4u*)(SXp + ra * 1024 + ch0), c1 = *(const v4u*)(SCp + rb * 1024 + ch0), x1 = *(const v4u*)(SXp + rb * 1024 + ch0);
#pragma unroll
                for (int q = 0; q < 4; ++q) { pm2[2 * q] = blo(c2[q]) * blo(x2[q]); pm2[2 * q + 1] = bhi(c2[q]) * bhi(x2[q]); pm1[2 * q] = blo(c1[q]) * blo(x1[q]); pm1[2 * q + 1] = bhi(c1[q]) * bhi(x1[q]); }
            }
            for (int rr = 0; rr < 8; ++rr) {
                const size_t r = (size_t)r0 + rr;
                const v4u cv = *(const v4u*)(SCp + r * 1024 + ch0), xv = *(const v4u*)(SXp + r * 1024 + ch0), bv = *(const v4u*)(SBp + r * 1024 + ch0);
                float p0[8], o[8];
#pragma unroll
                for (int q = 0; q < 4; ++q) { p0[2 * q] = blo(cv[q]) * blo(xv[q]); p0[2 * q + 1] = bhi(cv[q]) * bhi(xv[q]); }
#pragma unroll
                for (int q = 0; q < 4; ++q) { o[2 * q] = blo(bv[q]) * (w0[2 * q] * pm2[2 * q] + w1[2 * q] * pm1[2 * q] + w2[2 * q] * p0[2 * q]);
                    o[2 * q + 1] = bhi(bv[q]) * (w0[2 * q + 1] * pm2[2 * q + 1] + w1[2 * q + 1] * pm1[2 * q + 1] + w2[2 * q + 1] * p0[2 * q + 1]); }
                v4u o4; o4.x = pk2(o[0], o[1]); o4.y = pk2(o[2], o[3]); o4.z = pk2(o[4], o[5]); o4.w = pk2(o[6], o[7]);
                *(v4u*)(SCV + r * 1024 + ch0) = o4;
#pragma unroll
                for (int q = 0; q < 8; ++q) { pm2[q] = pm1[q]; pm1[q] = p0[q]; }
            }
            if (sl + 1 < NSLICE && s0 == SL - 8) {
#pragma unroll
                for (int q = 0; q < 8; ++q) { SCH[(b * 2 + 0) * 1024 + ch0 + q] = pm2[q]; SCH[(b * 2 + 1) * 1024 + ch0 + q] = pm1[q]; }
            }
        }
    }
}

__device__ __forceinline__ void phase_norm(Ctx& C, const Args& A, int sl) {
    const int gw = C.vcu * NWAVES + C.wave, NGW = C.G * NWAVES, lane = opq(C.tid) & 63;
    unsigned char* ws = opq_p(C.ws);
    const float* H1 = (const float*)(ws + WS_Z); bf16* U1 = (bf16*)(ws + WS_BM);
    for (int r = gw; r < RS; r += NGW) rms_row_bf16(H1 + (size_t)r * DM, A.in[I_LNFFN], U1 + (size_t)r * DM, lane);
    if (sl + 1 < NSLICE) for (int r = gw; r < RS; r += NGW) rms_row_bf16(u0_src(A, sl + 1, r), A.in[I_LNMIX], (bf16*)(ws + WS_U0) + (size_t)r * DM, lane);
}

__device__ __forceinline__ int med3i(int a, int b, int c) { int r; asm("v_med3_i32 %0, %1, %2, %3" : "=v"(r) : "v"(a), "v"(b), "v"(c)); return r; }
__device__ __forceinline__ int ord_key(float f) { int k = __builtin_bit_cast(int, f); return k ^ ((k >> 31) & 0x7fffffff); }
__device__ __forceinline__ float ord_val(int k) { return __builtin_bit_cast(float, k ^ ((k >> 31) & 0x7fffffff)); }
#define TK_INSERT(L, x) do { const int x_ = (x); \
    L[15] = med3i(L[14], x_, L[15]); L[14] = med3i(L[13], x_, L[14]); L[13] = med3i(L[12], x_, L[13]); L[12] = med3i(L[11], x_, L[12]); \
    L[11] = med3i(L[10], x_, L[11]); L[10] = med3i(L[9], x_, L[10]); L[9] = med3i(L[8], x_, L[9]); L[8] = med3i(L[7], x_, L[8]); \
    L[7] = med3i(L[6], x_, L[7]); L[6] = med3i(L[5], x_, L[6]); L[5] = med3i(L[4], x_, L[5]); L[4] = med3i(L[3], x_, L[4]); \
    L[3] = med3i(L[2], x_, L[3]); L[2] = med3i(L[1], x_, L[2]); L[1] = med3i(L[0], x_, L[1]); L[0] = max(L[0], x_); } while (0)
constexpr int TK_QS = 264;

__device__ __forceinline__ void phase_topk(Ctx& C) {
    const int lane = opq(C.tid) & 63;
    const int gw = C.vcu * NWAVES + C.wave, NGW = C.G * NWAVES, r32 = lane & 31, hf = lane >> 5;
    unsigned char* ws = opq_p(C.ws);
    const bf16* Q = (const bf16*)(ws + WS_GT); const bf16* SK = (const bf16*)(ws + WS_SK);
    int* EIDX = (int*)(ws + WS_SB); float* GW = (float*)(ws + WS_SB + 8 * MiB);
    LAS bf16* Qs = (LAS bf16*)(C.lds + C.wave * 17408);
    for (int task = gw; task < (RS / 32) * 8; task += NGW) {
        const int tb = task >> 3, hh = task & 7, r0 = tb * 32;
#pragma unroll
        for (int i = 0; i < 16; ++i) { const int piece = i * 64 + lane, row = piece >> 5, c16 = piece & 31;
            *(LAS v4u*)(Qs + row * TK_QS + c16 * 8) = *(const v4u*)(Q + (size_t)(r0 + row) * 2048 + hh * 256 + c16 * 8); }
        LDS_WAIT(); asm volatile("" ::: "memory");
        int LA[16], LB[16];
#pragma unroll
        for (int j = 0; j < 2; ++j) {
            f32x16 acc[4];
#pragma unroll
            for (int kb = 0; kb < 4; ++kb)
#pragma unroll
                for (int q = 0; q < 16; ++q) acc[kb][q] = 0.f;
            const bf16* skp = SK + (size_t)((hh * 2 + j) * 128 + r32) * 128 + hf * 8;
#pragma unroll 2
            for (int kk = 0; kk < 8; ++kk) {
                const bf16x8 bq = *(LAS bf16x8*)(Qs + r32 * TK_QS + j * 128 + kk * 16 + hf * 8);
#pragma unroll
                for (int kb = 0; kb < 4; ++kb) { const bf16x8 ak = *(const bf16x8*)(skp + (size_t)kb * 32 * 128 + kk * 16);
                    acc[kb] = __builtin_amdgcn_mfma_f32_32x32x16_bf16(ak, bq, acc[kb], 0, 0, 0); }
            }
            int L[16];
#pragma unroll
            for (int q = 0; q < 16; ++q) L[q] = (int)0x80000000;
#pragma unroll
            for (int kb = 0; kb < 4; ++kb)
#pragma unroll
                for (int q = 0; q < 16; ++q) { const int key = kb * 32 + (q & 3) + 8 * (q >> 2) + 4 * hf;
                    const int x = (ord_key(acc[kb][q]) & ~127) | (127 - key); TK_INSERT(L, x); }
            int T[16];
#pragma unroll
            for (int q = 0; q < 16; ++q) T[q] = __shfl_xor(L[q], 32);
#pragma unroll
            for (int q = 0; q < 16; ++q) TK_INSERT(L, T[q]);
            if (j == 0) {
#pragma unroll
                for (int q = 0; q < 16; ++q) LA[q] = L[q];
            } else {
#pragma unroll
                for (int q = 0; q < 16; ++q) LB[q] = L[q];
            }
        }
        float av[16], bv[16]; unsigned pa[4] = {0u, 0u, 0u, 0u}, pb[4] = {0u, 0u, 0u, 0u};
#pragma unroll
        for (int q = 0; q < 16; ++q) { av[q] = ord_val(LA[q] & ~127); bv[q] = ord_val(LB[q] & ~127);
            pa[q >> 2] |= (unsigned)(127 - (LA[q] & 127)) << (8 * (q & 3)); pb[q >> 2] |= (unsigned)(127 - (LB[q] & 127)) << (8 * (q & 3)); }
        int LC[16];
#pragma unroll
        for (int q = 0; q < 16; ++q) LC[q] = (int)0x80000000;
#pragma unroll
        for (int i = 0; i < 16; ++i)
#pragma unroll
            for (int jj = 0; jj < 16; ++jj)
                if ((i + 1) * (jj + 1) <= 16) { const int x = (ord_key(av[i] + bv[jj]) & ~255) | (255 - (i * 16 + jj)); TK_INSERT(LC, x); }
        float cs[16], es[16], esum = 0.f; int ei[16];
#pragma unroll
        for (int q = 0; q < 16; ++q) { cs[q] = ord_val(LC[q] & ~255); const int ci = 255 - (LC[q] & 255), i = ci >> 4, jj = ci & 15;
            const unsigned wa = (i < 8) ? ((i < 4) ? pa[0] : pa[1]) : ((i < 12) ? pa[2] : pa[3]);
            const unsigned wb = (jj < 8) ? ((jj < 4) ? pb[0] : pb[1]) : ((jj < 12) ? pb[2] : pb[3]);
            const int i1 = (wa >> (8 * (i & 3))) & 255, i2 = (wb >> (8 * (jj & 3))) & 255;
            ei[q] = i1 * 128 + i2; }
#pragma unroll
        for (int q = 0; q < 16; ++q) { es[q] = __expf(cs[q] - cs[0]); esum += es[q]; }
        const float rinv = 1.0f / esum;
        if (hf == 0) {
            int* ep = EIDX + (size_t)(r0 + r32) * 128 + hh * 16; float* gp = GW + (size_t)(r0 + r32) * 128 + hh * 16;
#pragma unroll
            for (int q = 0; q < 4; ++q) { *(int4*)(ep + 4 * q) = make_int4(ei[4 * q], ei[4 * q + 1], ei[4 * q + 2], ei[4 * q + 3]);
                *(f32x4*)(gp + 4 * q) = (f32x4){es[4 * q] * rinv, es[4 * q + 1] * rinv, es[4 * q + 2] * rinv, es[4 * q + 3] * rinv}; }
        }
        LDS_WAIT(); asm volatile("" ::: "memory");
    }
}

__device__ __forceinline__ float dot8(v4u a, v4u b) {
    float s = 0.f;
#pragma unroll
    for (int q = 0; q < 4; ++q) { s = fmaf(blo(a[q]), blo(b[q]), s); s = fmaf(bhi(a[q]), bhi(b[q]), s); }
    return s;
}
__device__ __forceinline__ float gelu_erf(float x) { return 0.5f * x * (1.0f + erff(x * 0.70710678118654752f)); }

__device__ __forceinline__ void phase_gather(Ctx& C, const Args& A, int sl) {
    const int gw = C.vcu * NWAVES + C.wave, lane = opq(C.tid) & 63;
    unsigned char* ws = opq_p(C.ws);
    const float* H1 = (const float*)(ws + WS_Z); const bf16* U1 = (const bf16*)(ws + WS_BM);
    const int* EIDX = (const int*)(ws + WS_SB); const float* GW = (const float*)(ws + WS_SB + 8 * MiB);
    const bf16* EU = (const bf16*)(ws + WS_EU); const bf16* EV = (const bf16*)(ws + WS_EV);
    const float* lnf = A.in[I_LNF];
    for (int tt = 0; tt < 8; ++tt) {
        const int r = gw * 8 + tt;
        const v4u ua = *(const v4u*)(U1 + (size_t)r * DM + 8 * lane), ub = *(const v4u*)(U1 + (size_t)r * DM + 512 + 8 * lane);
        const int e_lo = EIDX[(size_t)r * 128 + lane], e_hi = EIDX[(size_t)r * 128 + 64 + lane];
        const float g_lo = GW[(size_t)r * 128 + lane], g_hi = GW[(size_t)r * 128 + 64 + lane];
        float wreg[8];
#pragma unroll
        for (int grp = 0; grp < 8; ++grp) {
            float p[16];
#pragma unroll
            for (int k = 0; k < 16; ++k) { const int kk = grp * 16 + k; const int e = __builtin_amdgcn_readlane((kk < 64) ? e_lo : e_hi, kk & 63);
                const bf16* row = EU + (size_t)e * DM;
                const v4u ra = *(const v4u*)(row + 8 * lane), rb = *(const v4u*)(row + 512 + 8 * lane);
                p[k] = dot8(ra, ua) + dot8(rb, ub); }
            float q8[8], q4[4], q2[2], q1;
            { const bool bt = lane & 1;
#pragma unroll
              for (int m = 0; m < 8; ++m) { const float keep = bt ? p[2 * m + 1] : p[2 * m], send = bt ? p[2 * m] : p[2 * m + 1]; q8[m] = keep + __shfl_xor(send, 1); } }
            { const bool bt = lane & 2;
#pragma unroll
              for (int m = 0; m < 4; ++m) { const float keep = bt ? q8[2 * m + 1] : q8[2 * m], send = bt ? q8[2 * m] : q8[2 * m + 1]; q4[m] = keep + __shfl_xor(send, 2); } }
            { const bool bt = lane & 4;
#pragma unroll
              for (int m = 0; m < 2; ++m) { const float keep = bt ? q4[2 * m + 1] : q4[2 * m], send = bt ? q4[2 * m] : q4[2 * m + 1]; q2[m] = keep + __shfl_xor(send, 4); } }
            { const bool bt = lane & 8; const float keep = bt ? q2[1] : q2[0], send = bt ? q2[0] : q2[1]; q1 = keep + __shfl_xor(send, 8); }
            q1 += __shfl_xor(q1, 16); q1 += __shfl_xor(q1, 32);
            const float gsel = __shfl((grp < 4) ? g_lo : g_hi, (grp * 16 + (lane & 15)) & 63);
            wreg[grp] = gelu_erf(q1) * gsel;
        }
        float acc[16];
#pragma unroll
        for (int q = 0; q < 16; ++q) acc[q] = 0.f;
#pragma unroll
        for (int grp = 0; grp < 8; ++grp) {
#pragma unroll
            for (int k = 0; k < 16; ++k) { const int kk = grp * 16 + k; const int e = __builtin_amdgcn_readlane((kk < 64) ? e_lo : e_hi, kk & 63);
                const float w = __builtin_bit_cast(float, __builtin_amdgcn_readlane(__builtin_bit_cast(int, wreg[grp]), k));
                const bf16* row = EV + (size_t)e * DM;
                const v4u ra = *(const v4u*)(row + 8 * lane), rb = *(const v4u*)(row + 512 + 8 * lane);
#pragma unroll
                for (int q = 0; q < 4; ++q) { acc[2 * q] = fmaf(w, blo(ra[q]), acc[2 * q]); acc[2 * q + 1] = fmaf(w, bhi(ra[q]), acc[2 * q + 1]);
                    acc[8 + 2 * q] = fmaf(w, blo(rb[q]), acc[8 + 2 * q]); acc[8 + 2 * q + 1] = fmaf(w, bhi(rb[q]), acc[8 + 2 * q + 1]); } }
        }
        const float* hp = H1 + (size_t)r * DM;
        f32x4 hv[4]; hv[0] = *(const f32x4*)(hp + 8 * lane); hv[1] = *(const f32x4*)(hp + 8 * lane + 4); hv[2] = *(const f32x4*)(hp + 512 + 8 * lane); hv[3] = *(const f32x4*)(hp + 512 + 8 * lane + 4);
        float ss = 0.f;
#pragma unroll
        for (int q = 0; q < 4; ++q)
#pragma unroll
            for (int e = 0; e < 4; ++e) { hv[q][e] += acc[4 * q + e]; ss += hv[q][e] * hv[q][e]; }
        const float rs = rsqrtf(wave_sum(ss) * (1.f / 1024.f) + EPS);
        float* op = C.out + ((size_t)(r >> 11) * SEQ + sl * SL + (r & (SL - 1))) * DM;
        const f32x4 g0 = *(const f32x4*)(lnf + 8 * lane), g1 = *(const f32x4*)(lnf + 8 * lane + 4), g2 = *(const f32x4*)(lnf + 512 + 8 * lane), g3 = *(const f32x4*)(lnf + 512 + 8 * lane + 4);
        *(f32x4*)(op + 8 * lane) = hv[0] * rs * g0; *(f32x4*)(op + 8 * lane + 4) = hv[1] * rs * g1; *(f32x4*)(op + 512 + 8 * lane) = hv[2] * rs * g2; *(f32x4*)(op + 512 + 8 * lane + 4) = hv[3] * rs * g3;
    }
}

#ifndef MK_PER_PHASE
#define MK_PER_PHASE 0
#endif
constexpr int PH_PER_SLICE = 10, N_PHASES = 1 + NSLICE * PH_PER_SLICE;

__global__ void __launch_bounds__(NWAVES * 64, 2) mk_fwd(Args args) {
    extern __shared__ __attribute__((aligned(16))) unsigned char lds_[];
    Ctx C;
    C.lds = (LAS unsigned char*)lds_;
    C.tid = threadIdx.x; C.lane = C.tid & 63; C.wave = __builtin_amdgcn_readfirstlane(C.tid >> 6);
    C.G = gridDim.x; { const int bx = blockIdx.x; C.vcu = (C.G % 8 == 0) ? (bx % 8) * (C.G / 8) + bx / 8 : bx; }
    C.out = args.out; C.ws = args.ws;
    unsigned char* ws = args.ws;
    volatile LAS unsigned* MISC = (volatile LAS unsigned*)(C.lds + MISC_OFF);
    if (C.tid < 64) MISC[C.tid] = 0u;
    __syncthreads();
    unsigned* barw = (unsigned*)(ws + WS_CTL) + CW_BAR;
    XcdBarrier bar; bar.bar = barw; bar.x = 0; bar.st = nullptr;
    const int lo = args.ph_lo, hi = args.ph_hi;
    if (hi - lo > 1) bar = xcd_barrier_post(barw, MISC + 8);
#define SEAM(id) do { if ((id) + 1 < hi) xcd_barrier(bar); } while (0)
#ifndef ONLY
#define ONLY -1
#endif
#define KIND(k) (ONLY < 0 || ONLY == (k))
#define IN(id) (lo <= (id) && (id) < hi)

    if (KIND(0) && IN(0)) { phase_prep(C, args); SEAM(0); }
    for (int sl = 0; sl < NSLICE; ++sl) {
        const int base = 1 + sl * PH_PER_SLICE;
        ws = opq_p(ws);
        if (KIND(1) && IN(base + 0)) {
            const int Mrows = (sl == 0) ? RP : RS;
            pg8::Gemm g{(const bf16*)(ws + WS_U0), (const bf16*)(ws + WS_WIN), Mrows, NPROJ, DM}; pg8::StaticOrder S; S.init(Mrows, NPROJ, C.G, (int)blockIdx.x);
            pg8::EpiProj E{(bf16*)(ws + WS_Z), (bf16*)(ws + WS_XS), (bf16*)(ws + WS_BM), (bf16*)(ws + WS_CM), (bf16*)(ws + WS_SB), (bf16*)(ws + WS_SC), (bf16*)(ws + WS_SX), (bf16*)(ws + WS_GT), (float*)(ws + WS_DT)};
            pg8::gemm_phase<pg8::EpiProj, pg8::StaticOrder, true, true>(C.lds, g, S, E);
            SEAM(base + 0);
        }
        if (KIND(2) && IN(base + 1)) { phase_scan(C, args, sl); SEAM(base + 1); }
        if (KIND(3) && IN(base + 2)) { phase_elem(C, args, sl); SEAM(base + 2); }
        if (KIND(4) && IN(base + 3)) {
            pg8::Gemm g{(const bf16*)(ws + WS_XS), (const bf16*)(ws + WS_WSSD), RS, DM, 2048}; pg8::StaticOrder S; S.init(RS, DM, C.G, (int)blockIdx.x);
            pg8::EpiF32Plain E{(float*)(ws + WS_BM), DM};
            pg8::gemm_phase<pg8::EpiF32Plain, pg8::StaticOrder, true, true>(C.lds, g, S, E);
            SEAM(base + 3);
        }
        if (KIND(5) && IN(base + 4)) {
            pg8::Gemm g{(const bf16*)(ws + WS_U0), (const bf16*)(ws + WS_WSC), RS, DM, DM}; pg8::StaticOrder S; S.init(RS, DM, C.G, (int)blockIdx.x);
            pg8::EpiMerge E{(const float*)(ws + WS_BM), (const bf16*)(ws + WS_GT), (bf16*)(ws + WS_SX)};
            pg8::gemm_phase<pg8::EpiMerge, pg8::StaticOrder, true, true>(C.lds, g, S, E);
            SEAM(base + 4);
        }
        if (KIND(6) && IN(base + 5)) {
            pg8::Gemm g{(const bf16*)(ws + WS_SX), (const bf16*)(ws + WS_WO), RS, DM, DM}; pg8::StaticOrder S; S.init(RS, DM, C.G, (int)blockIdx.x);
            pg8::EpiWo E{args.in[I_X], (float*)(ws + WS_Z), sl * SL};
            pg8::gemm_phase<pg8::EpiWo, pg8::StaticOrder, true, true>(C.lds, g, S, E);
            SEAM(base + 5);
        }
        if (KIND(7) && IN(base + 6)) { phase_norm(C, args, sl); SEAM(base + 6); }
        if (KIND(8) && IN(base + 7)) {
            pg8::Gemm g{(const bf16*)(ws + WS_BM), (const bf16*)(ws + WS_WQ), RS, 2048, DM}; pg8::StaticOrder S; S.init(RS, 2048, C.G, (int)blockIdx.x);
            pg8::EpiBf16Plain E{(bf16*)(ws + WS_GT), 2048};
            pg8::gemm_phase<pg8::EpiBf16Plain, pg8::StaticOrder, true, true>(C.lds, g, S, E);
            SEAM(base + 7);
        }
        if (KIND(9) && IN(base + 8)) { phase_topk(C); SEAM(base + 8); }
        if (KIND(10) && IN(base + 9)) { phase_gather(C, args, sl); SEAM(base + 9); }
    }
#undef SEAM
#undef IN
}

extern "C" void kernel_launch(void* const* d_in, const int* in_sizes, int n_in, void* d_out, int out_size, void* d_ws, size_t ws_size, hipStream_t stream) {
    static int ready = 0;
    if (ready == 0) {
        if (n_in != 20 || ws_size < WS_END) { fprintf(stderr, "kernel_launch: unexpected inputs (n_in %d, ws %zu)\n", n_in, ws_size); ready = -1; return; }
        if (hipFuncSetAttribute((const void*)mk_fwd, hipFuncAttributeMaxDynamicSharedMemorySize, LDS_BYTES) != hipSuccess) { fprintf(stderr, "kernel_launch: hipFuncSetAttribute failed\n"); ready = -1; return; }
        ready = 1;
    }
    if (ready < 0) return;
    (void)hipMemsetAsync((char*)d_ws + WS_CTL, 0, CTL_ZERO_BYTES, stream);
    Args a{};
    for (int i = 0; i < 20; ++i) a.in[i] = (const float*)d_in[i];
    a.out = (float*)d_out; a.ws = (unsigned char*)d_ws;
    const int grid = 256;
#if MK_PER_PHASE
    for (int p = 0; p < N_PHASES; ++p) { a.ph_lo = p; a.ph_hi = p + 1; hipLaunchKernelGGL(mk_fwd, dim3(grid), dim3(NWAVES * 64), LDS_BYTES, stream, a); }
#else
    a.ph_lo = 0; a.ph_hi = N_PHASES;
    hipLaunchKernelGGL(mk_fwd, dim3(grid), dim3(NWAVES * 64), LDS_BYTES, stream, a);
#endif
}
```

```cpp
#include <hip/hip_runtime.h>
#include <cstdio>
#include <cstdint>
#include <cmath>
namespace pg8 {
#define PG8_LAS __attribute__((address_space(3)))
typedef unsigned short bf16_t;
typedef short bf16x8 __attribute__((ext_vector_type(8)));
typedef float f32x4 __attribute__((ext_vector_type(4)));
typedef unsigned u32x4 __attribute__((ext_vector_type(4)));
constexpr int BM = 256, BK = 64, HALF = 128, HTB = HALF * BK * 2  , STAGE_BYTES = 8 * HTB, NXCD = 8, WGM = 8;

__host__ __device__ __forceinline__ int lds_byte(int r, int c) { const int st = (r >> 4) * 2 + (c >> 5), rr = r & 15, cc = c & 31, ob = rr * 64 + cc * 2; return st * 1024 + (ob ^ (((ob >> 9) & 1) << 5)); }
__host__ __device__ __forceinline__ void stage_rc(int b, int& R, int& C) { const int st = b / 1024, sb = b % 1024, swz = sb ^ (((sb >> 9) & 1) << 5); R = (st >> 1) * 16 + swz / 64; C = (st & 1) * 32 + (swz % 64) / 2; }
__host__ __device__ __forceinline__ int perm32(int rho) { const int n = rho >> 4, i = rho & 15; return 8 * (i >> 2) + 4 * n + (i & 3); }

struct Unit { int pm, pn; };
struct Gemm { const bf16_t* A; const bf16_t* Bt; int M, N, K; };

struct StaticOrder {
    int nM, nN, nwg, G, c;
    __host__ __device__ void init(int M, int N, int G_, int c_) { nM = M / BM; nN = N / BM; nwg = nM * nN; G = G_; c = c_; }
    __host__ __device__ bool next(int i, Unit& u) const {
        const long L = (long)i * G + c; if (L >= nwg) return false;
        int wgid = (int)L; { const int q = nwg / NXCD, r = nwg % NXCD, xcd = wgid % NXCD, off = wgid / NXCD; wgid = (xcd < r ? xcd * (q + 1) : r * (q + 1) + (xcd - r) * q) + off; }
        const int nig = WGM * nN, gid = wgid / nig, fm = gid * WGM, gsz = (nM - fm) < WGM ? (nM - fm) : WGM;
        u.pm = fm + ((wgid % nig) % gsz); u.pn = (wgid % nig) / gsz; return true;
    }
    __device__ __forceinline__ void a_ready(const Unit&) const {}
    __device__ __forceinline__ void done(const Unit&) const {}
};

__device__ __forceinline__ unsigned cvt_pk_bf16(float lo, float hi) { unsigned r; asm volatile("v_cvt_pk_bf16_f32 %0, %1, %2" : "=v"(r) : "v"(lo), "v"(hi)); return r; }
typedef float f32x2 __attribute__((ext_vector_type(2)));
__device__ __forceinline__ float fast_sigmoid(float x) { return __builtin_amdgcn_rcpf(1.0f + __expf(-x)); }
__device__ __forceinline__ float bflo(unsigned u) { return __builtin_bit_cast(float, u << 16); }
__device__ __forceinline__ float bfhi(unsigned u) { return __builtin_bit_cast(float, u & 0xffff0000u); }

struct EpiProj {
    static constexpr bool PERM = true, AFTER_DRAIN = false;
    bf16_t *Zb, *XS, *BMb, *CMb, *SBb, *SCb, *SXb, *GT; float* DT;
    __device__ __forceinline__ void operator()(const f32x4 (&acc)[2][2][4][2], const Unit& u, int wr, int wc, int fr, int fq) const {
        const int row0 = u.pm * BM + wr * 64 + fr; const int pn = u.pn;
        if (pn == 44) {
            if (wc == 0) {
#pragma unroll
                for (int ai = 0; ai < 2; ++ai)
#pragma unroll
                    for (int m = 0; m < 4; ++m) { float* rp = DT + (size_t)(row0 + ai * HALF + m * 16) * 32 + 8 * fq;
                        *(f32x4*)(rp) = acc[ai][0][m][0]; *(f32x4*)(rp + 4) = acc[ai][0][m][1]; }
            }
            return;
        }
        bf16_t* base; int ld, colt;
        if (pn < 8) { base = Zb; ld = 2048; colt = pn * 256; }
        else if (pn < 16) { base = XS; ld = 2048; colt = (pn - 8) * 256; }
        else if (pn < 20) { base = BMb; ld = 1024; colt = (pn - 16) * 256; }
        else if (pn < 24) { base = CMb; ld = 1024; colt = (pn - 20) * 256; }
        else if (pn < 28) { base = SBb; ld = 1024; colt = (pn - 24) * 256; }
        else if (pn < 32) { base = SCb; ld = 1024; colt = (pn - 28) * 256; }
        else if (pn < 36) { base = SXb; ld = 1024; colt = (pn - 32) * 256; }
        else { base = GT; ld = 2048; colt = (pn - 36) * 256; }
        const int col0 = colt + wc * 32 + 8 * fq;
#pragma unroll
        for (int ai = 0; ai < 2; ++ai)
#pragma unroll
            for (int m = 0; m < 4; ++m) { bf16_t* rowp = base + (size_t)(row0 + ai * HALF + m * 16) * ld + col0;
#pragma unroll
                for (int bj = 0; bj < 2; ++bj) { const f32x4 v0 = acc[ai][bj][m][0], v1 = acc[ai][bj][m][1];
                    u32x4 w; w.x = cvt_pk_bf16(v0[0], v0[1]); w.y = cvt_pk_bf16(v0[2], v0[3]); w.z = cvt_pk_bf16(v1[0], v1[1]); w.w = cvt_pk_bf16(v1[2], v1[3]);
                    *(u32x4*)(rowp + bj * HALF) = w; } }
    }
};
struct EpiBf16Plain {
    static constexpr bool PERM = true, AFTER_DRAIN = false;
    bf16_t* O; int ldc;
    __device__ __forceinline__ void operator()(const f32x4 (&acc)[2][2][4][2], const Unit& u, int wr, int wc, int fr, int fq) const {
        const int row0 = u.pm * BM + wr * 64 + fr; const int col0 = u.pn * BM + wc * 32 + 8 * fq;
#pragma unroll
        for (int ai = 0; ai < 2; ++ai)
#pragma unroll
            for (int m = 0; m < 4; ++m) { bf16_t* rowp = O + (size_t)(row0 + ai * HALF + m * 16) * ldc + col0;
#pragma unroll
                for (int bj = 0; bj < 2; ++bj) { const f32x4 v0 = acc[ai][bj][m][0], v1 = acc[ai][bj][m][1];
                    u32x4 w; w.x = cvt_pk_bf16(v0[0], v0[1]); w.y = cvt_pk_bf16(v0[2], v0[3]); w.z = cvt_pk_bf16(v1[0], v1[1]); w.w = cvt_pk_bf16(v1[2], v1[3]);
                    *(u32x4*)(rowp + bj * HALF) = w; } }
    }
};
struct EpiF32Plain {
    static constexpr bool PERM = false, AFTER_DRAIN = false;
    float* C; int ldc;
    __device__ __forceinline__ void operator()(const f32x4 (&acc)[2][2][4][2], const Unit& u, int wr, int wc, int fr, int fq) const {
        const int row0 = u.pm * BM + wr * 64 + fr, col0 = u.pn * BM + wc * 32 + 4 * fq;
#pragma unroll
        for (int ai = 0; ai < 2; ++ai)
#pragma unroll
            for (int m = 0; m < 4; ++m) { float* rowp = C + (size_t)(row0 + ai * HALF + m * 16) * ldc + col0;
#pragma unroll
                for (int bj = 0; bj < 2; ++bj)
#pragma unroll
                    for (int n = 0; n < 2; ++n) *(f32x4*)(rowp + bj * HALF + n * 16) = acc[ai][bj][m][n]; }
    }
};
struct EpiMerge {
    static constexpr bool PERM = false, AFTER_DRAIN = false;
    const float* YS; const bf16_t* GT; bf16_t* O;
    __device__ __forceinline__ void operator()(const f32x4 (&acc)[2][2][4][2], const Unit& u, int wr, int wc, int fr, int fq) const {
        const int row0 = u.pm * BM + wr * 64 + fr, col0 = u.pn * BM + wc * 32 + 4 * fq;
#pragma unroll
        for (int ai = 0; ai < 2; ++ai)
#pragma unroll
            for (int m = 0; m < 4; ++m) { const size_t row = (size_t)(row0 + ai * HALF + m * 16);
#pragma unroll
                for (int bj = 0; bj < 2; ++bj)
#pragma unroll
                    for (int n = 0; n < 2; ++n) { const int col = col0 + bj * HALF + n * 16;
                        const f32x4 ys = *(const f32x4*)(YS + row * 1024 + col);
                        const uint2 g1 = *(const uint2*)(GT + row * 2048 + col), g2 = *(const uint2*)(GT + row * 2048 + 1024 + col);
                        const f32x4 a = acc[ai][bj][m][n];
                        const float o0 = fast_sigmoid(bflo(g1.x)) * ys[0] + fast_sigmoid(bflo(g2.x)) * a[0];
                        const float o1 = fast_sigmoid(bfhi(g1.x)) * ys[1] + fast_sigmoid(bfhi(g2.x)) * a[1];
                        const float o2 = fast_sigmoid(bflo(g1.y)) * ys[2] + fast_sigmoid(bflo(g2.y)) * a[2];
                        const float o3 = fast_sigmoid(bfhi(g1.y)) * ys[3] + fast_sigmoid(bfhi(g2.y)) * a[3];
                        uint2 w; w.x = cvt_pk_bf16(o0, o1); w.y = cvt_pk_bf16(o2, o3);
                        *(uint2*)(O + row * 1024 + col) = w; } }
    }
};
struct EpiWo {
    static constexpr bool PERM = false, AFTER_DRAIN = false;
    const float* X; float* H1; int soff;
    __device__ __forceinline__ void operator()(const f32x4 (&acc)[2][2][4][2], const Unit& u, int wr, int wc, int fr, int fq) const {
        const int row0 = u.pm * BM + wr * 64 + fr, col0 = u.pn * BM + wc * 32 + 4 * fq;
#pragma unroll
        for (int ai = 0; ai < 2; ++ai)
#pragma unroll
            for (int m = 0; m < 4; ++m) { const int r = row0 + ai * HALF + m * 16; const size_t xr = (size_t)((r >> 11) * 4096 + soff + (r & 2047));
                const float* xp = X + xr * 1024 + col0; float* hp = H1 + (size_t)r * 1024 + col0;
#pragma unroll
                for (int bj = 0; bj < 2; ++bj)
#pragma unroll
                    for (int n = 0; n < 2; ++n) *(f32x4*)(hp + bj * HALF + n * 16) = *(const f32x4*)(xp + bj * HALF + n * 16) + acc[ai][bj][m][n]; }
    }
};
template <class Epi, class Sched, bool ALIGN_EPI = false, bool SP2 = false>
__device__ __forceinline__ void gemm_phase(PG8_LAS unsigned char* lds, const Gemm g, const Sched& S, const Epi& E) {
    int tid_ = threadIdx.x; asm volatile("" : "+v"(tid_)); const int tid = tid_, wid = __builtin_amdgcn_readfirstlane(tid >> 6), lane = tid & 63, wr = wid >> 2, wc = wid & 3, fr = lane & 15, fq = lane >> 4;
    const int K = g.K, nt = K / BK;
    unsigned voffA[2], voffB[2];
#pragma unroll
    for (int i = 0; i < 2; ++i) { int R, C; stage_rc(tid * 16 + i * 8192, R, C); const int Rb = Epi::PERM ? ((R & ~31) + perm32(R & 31)) : R;
        voffA[i] = (unsigned)(R * K + C) * 2u; voffB[i] = (unsigned)(Rb * K + C) * 2u; }
    const size_t kstep = (size_t)(BK * 2);
    const size_t hstep = (size_t)HALF * K * 2;
    const size_t tstep = 2 * hstep;
    const unsigned ldsw = (unsigned)wid * 1024u;
    const int aoff = lds_byte(wr * 64 + fr, fq * 8), boff = lds_byte(wc * 32 + fr, fq * 8);
#define PG8_SA(b, h) (((b) * 2 + (h)) * HTB)
#define PG8_SB(b, h) ((4 + (b) * 2 + (h)) * HTB)
#define PG8_STAGE(bufoff, gbase, voff) do { _Pragma("unroll") for (int _i = 0; _i < 2; ++_i) \
        __builtin_amdgcn_global_load_lds((const unsigned*)((const char*)(gbase) + (voff)[_i]), (PG8_LAS unsigned*)(lds + (bufoff) + ldsw + _i * 8192), 16, 0, 0); } while (0)
#define PG8_LDA(dst, b, h) do { _Pragma("unroll") for (int m = 0; m < 4; ++m) _Pragma("unroll") for (int k = 0; k < 2; ++k) dst[m][k] = *(const PG8_LAS bf16x8*)(lds + PG8_SA(b, h) + aoff + m * 2048 + k * 1024); } while (0)
#define PG8_LDB(dst, b, h) do { _Pragma("unroll") for (int n = 0; n < 2; ++n) _Pragma("unroll") for (int k = 0; k < 2; ++k) dst[n][k] = *(const PG8_LAS bf16x8*)(lds + PG8_SB(b, h) + boff + n * 2048 + k * 1024); } while (0)
#define PG8_MMA(ai, bj, At, Bt) do { __builtin_amdgcn_s_setprio(1); _Pragma("unroll") for (int m = 0; m < 4; ++m) _Pragma("unroll") for (int n = 0; n < 2; ++n) _Pragma("unroll") for (int k = 0; k < 2; ++k) \
        acc[ai][bj][m][n] = __builtin_amdgcn_mfma_f32_16x16x32_bf16(Bt[n][k], At[m][k], acc[ai][bj][m][n], 0, 0, 0); __builtin_amdgcn_s_setprio(0); } while (0)
#define PG8_WAIT_V(n) asm volatile("s_waitcnt vmcnt(" #n ")" ::: "memory")
#define PG8_WAIT_L(n) asm volatile("s_waitcnt lgkmcnt(" #n ")" ::: "memory")
#define PG8_BAR __builtin_amdgcn_s_barrier()
#define PG8_SCHED __builtin_amdgcn_sched_barrier(0)
    Unit cur, nxt; int ui = 0;
    if (!S.next(0, cur)) return;
    f32x4 acc[2][2][4][2];
#pragma unroll
    for (int a = 0; a < 2; ++a)
#pragma unroll
        for (int b = 0; b < 2; ++b)
#pragma unroll
            for (int m = 0; m < 4; ++m)
#pragma unroll
                for (int n = 0; n < 2; ++n) acc[a][b][m][n] = (f32x4){0.f, 0.f, 0.f, 0.f};
    bf16x8 At[4][2], B0[2][2], B1[2][2];
    const char* cA = (const char*)g.A + (size_t)cur.pm * tstep; const char* cB = (const char*)g.Bt + (size_t)cur.pn * tstep;
    S.a_ready(cur);
    if constexpr (SP2) {
        PG8_STAGE(PG8_SB(0, 0), cB, voffB); PG8_STAGE(PG8_SB(0, 1), cB + hstep, voffB); PG8_STAGE(PG8_SA(0, 0), cA, voffA); PG8_STAGE(PG8_SA(0, 1), cA + hstep, voffA);
        if (wr == 1) PG8_BAR;
        PG8_WAIT_V(2); PG8_BAR;
        PG8_STAGE(PG8_SB(1, 0), cB + kstep, voffB); PG8_STAGE(PG8_SA(1, 0), cA + kstep, voffA); PG8_STAGE(PG8_SB(1, 1), cB + hstep + kstep, voffB);
        PG8_WAIT_V(6); PG8_BAR;
    } else {
        PG8_STAGE(PG8_SB(0, 0), cB, voffB); PG8_STAGE(PG8_SA(0, 0), cA, voffA); PG8_STAGE(PG8_SB(0, 1), cB + hstep, voffB); PG8_STAGE(PG8_SA(0, 1), cA + hstep, voffA);
        if (wr == 1) PG8_BAR;
        PG8_WAIT_V(4); PG8_BAR;
        PG8_STAGE(PG8_SB(1, 0), cB + kstep, voffB); PG8_STAGE(PG8_SA(1, 0), cA + kstep, voffA); PG8_STAGE(PG8_SB(1, 1), cB + hstep + kstep, voffB);
        PG8_WAIT_V(6); PG8_BAR;
    }
    for (;;) {
        const bool has_next = S.next(ui + 1, nxt);
        const char* nA = has_next ? (const char*)g.A + (size_t)nxt.pm * tstep : cA; const char* nB = has_next ? (const char*)g.Bt + (size_t)nxt.pn * tstep : cB;
        for (int t = 0; t < nt; t += 2) {
            const bool last = (t == nt - 2);
            const char* a1 = cA + (size_t)(t + 1) * kstep;
            const char* a2 = last ? nA : cA + (size_t)(t + 2) * kstep; const char* b2 = last ? nB : cB + (size_t)(t + 2) * kstep;
            const char* a3 = a2 + kstep; const char* b3 = b2 + kstep;
            if (last && has_next) S.a_ready(nxt);
            if constexpr (SP2) {
            PG8_LDB(B0, 0, 0); PG8_LDB(B1, 0, 1); PG8_SCHED; PG8_LDA(At, 0, 0); PG8_STAGE(PG8_SA(1, 1), a1 + hstep, voffA);
            PG8_WAIT_V(8); PG8_WAIT_L(0); PG8_BAR; PG8_MMA(0, 0, At, B0); PG8_MMA(0, 1, At, B1); PG8_BAR; PG8_SCHED;
            PG8_LDA(At, 0, 1); PG8_STAGE(PG8_SB(0, 0), b2, voffB); PG8_STAGE(PG8_SB(0, 1), b2 + hstep, voffB); PG8_STAGE(PG8_SA(0, 0), a2, voffA);
            PG8_WAIT_V(8); PG8_WAIT_L(0); PG8_BAR; PG8_MMA(1, 0, At, B0); PG8_MMA(1, 1, At, B1); PG8_BAR; PG8_SCHED;
            PG8_LDB(B0, 1, 0); PG8_LDB(B1, 1, 1); PG8_SCHED; PG8_LDA(At, 1, 0); PG8_STAGE(PG8_SA(0, 1), a2 + hstep, voffA);
            PG8_WAIT_V(8); PG8_WAIT_L(0); PG8_BAR; PG8_MMA(0, 0, At, B0); PG8_MMA(0, 1, At, B1); PG8_BAR; PG8_SCHED;
            PG8_LDA(At, 1, 1); PG8_STAGE(PG8_SB(1, 0), b3, voffB); PG8_STAGE(PG8_SB(1, 1), b3 + hstep, voffB); PG8_STAGE(PG8_SA(1, 0), a3, voffA);
            PG8_WAIT_V(8); PG8_WAIT_L(0); PG8_BAR; PG8_MMA(1, 0, At, B0); PG8_MMA(1, 1, At, B1); PG8_BAR; PG8_SCHED;
            } else {
            PG8_LDB(B0, 0, 0); PG8_SCHED; PG8_LDA(At, 0, 0); PG8_STAGE(PG8_SA(1, 1), a1 + hstep, voffA);
            PG8_WAIT_L(8); PG8_BAR; PG8_WAIT_L(0); PG8_MMA(0, 0, At, B0); PG8_BAR; PG8_SCHED;
            PG8_LDB(B1, 0, 1); PG8_STAGE(PG8_SB(0, 0), b2, voffB);
            PG8_BAR; PG8_WAIT_L(0); PG8_MMA(0, 1, At, B1); PG8_BAR;
            PG8_LDA(At, 0, 1); PG8_STAGE(PG8_SA(0, 0), a2, voffA);
            PG8_BAR; PG8_WAIT_L(0); PG8_MMA(1, 0, At, B0); PG8_BAR; PG8_SCHED;
            PG8_STAGE(PG8_SB(0, 1), b2 + hstep, voffB);
            PG8_WAIT_V(6); PG8_BAR; PG8_MMA(1, 1, At, B1); PG8_BAR;
            PG8_LDB(B0, 1, 0); PG8_SCHED; PG8_LDA(At, 1, 0); PG8_STAGE(PG8_SA(0, 1), a2 + hstep, voffA);
            PG8_WAIT_L(8); PG8_BAR; PG8_WAIT_L(0); PG8_MMA(0, 0, At, B0); PG8_BAR; PG8_SCHED;
            PG8_LDB(B1, 1, 1); PG8_STAGE(PG8_SB(1, 0), b3, voffB);
            PG8_BAR; PG8_WAIT_L(0); PG8_MMA(0, 1, At, B1); PG8_BAR;
            PG8_LDA(At, 1, 1); PG8_STAGE(PG8_SA(1, 0), a3, voffA);
            PG8_BAR; PG8_WAIT_L(0); PG8_MMA(1, 0, At, B0); PG8_BAR; PG8_SCHED;
            PG8_STAGE(PG8_SB(1, 1), b3 + hstep, voffB);
            PG8_WAIT_V(6); PG8_BAR; PG8_MMA(1, 1, At, B1); PG8_BAR;
            }
        }
        if constexpr (ALIGN_EPI) { if (wr == 0) PG8_BAR; }
        if constexpr (!Epi::AFTER_DRAIN) { E(acc, cur, wr, wc, fr, fq); S.done(cur); }
        if (!has_next) break;
#pragma unroll
        for (int a = 0; a < 2; ++a)
#pragma unroll
            for (int b = 0; b < 2; ++b)
#pragma unroll
                for (int m = 0; m < 4; ++m)
#pragma unroll
                    for (int n = 0; n < 2; ++n) acc[a][b][m][n] = (f32x4){0.f, 0.f, 0.f, 0.f};
        cur = nxt; cA = nA; cB = nB; ++ui;
        if constexpr (ALIGN_EPI) { if (wr == 1) PG8_BAR; }
    }
    PG8_WAIT_V(0);
    if constexpr (!ALIGN_EPI) { if (wr == 0) PG8_BAR; }
    PG8_BAR;
    if constexpr (Epi::AFTER_DRAIN) { E.fused(acc, cur, wr, wc, fr, fq, lds, wid, lane); S.done(cur); }
#undef PG8_SA
#undef PG8_SB
#undef PG8_STAGE
#undef PG8_LDA
#undef PG8_LDB
#undef PG8_MMA
#undef PG8_WAIT_V
#undef PG8_WAIT_L
#undef PG8_BAR
#undef PG8_SCHED
}
}

#define GAS __attribute__((address_space(1)))
#define LAS __attribute__((address_space(3)))
typedef unsigned short bf16;
typedef unsigned v4u __attribute__((ext_vector_type(4)));
typedef unsigned v2u __attribute__((ext_vector_type(2)));
typedef float f32x4 __attribute__((ext_vector_type(4)));
typedef float f32x16 __attribute__((ext_vector_type(16)));
typedef short bf16x8 __attribute__((ext_vector_type(8)));
#define LDS_WAIT() asm volatile("s_waitcnt lgkmcnt(0)" ::: "memory")
#define VM_WAIT() asm volatile("s_waitcnt vmcnt(0)" ::: "memory")

constexpr int NB = 8, SEQ = 4096, DM = 1024, NSLICE = 2, SL = SEQ / NSLICE, RS = NB * SL, RP = RS + 256;
constexpr int NPROJ = 11520;
constexpr float EPS = 1e-6f;
constexpr int NWAVES = 8;
constexpr size_t MiB = 1u << 20;
constexpr size_t WS_CTL = 0, CTL_ZERO_BYTES = 1 * MiB;
constexpr size_t WS_WIN = 1 * MiB;
constexpr size_t WS_WSSD = WS_WIN + 23592960;
constexpr size_t WS_WSC = WS_WSSD + 4 * MiB;
constexpr size_t WS_WO = WS_WSC + 2 * MiB;
constexpr size_t WS_WQ = WS_WO + 2 * MiB;
constexpr size_t WS_SK = WS_WQ + 4 * MiB;
constexpr size_t WS_EU = WS_SK + MiB / 2;
constexpr size_t WS_EV = WS_EU + 16 * MiB;
constexpr size_t WS_SU = WS_EV + 16 * MiB;
constexpr size_t WS_SV = WS_SU + MiB / 4;
constexpr size_t WS_STATE = WS_SV + MiB / 4;
constexpr size_t WS_HALO = WS_STATE + 8 * MiB;
constexpr size_t WS_SCH = WS_HALO + MiB / 2;
constexpr size_t WS_U0 = WS_SCH + MiB / 2;
constexpr size_t SZ_R1 = (size_t)RP * 1024 * 2;
constexpr size_t WS_Z = WS_U0 + SZ_R1;
constexpr size_t WS_XS = WS_Z + 2 * SZ_R1;
constexpr size_t WS_BM = WS_XS + 2 * SZ_R1;
constexpr size_t WS_CM = WS_BM + SZ_R1;
constexpr size_t WS_DT = WS_CM + SZ_R1;
constexpr size_t WS_SB = WS_DT + 5 * MiB / 2;
constexpr size_t WS_SC = WS_SB + SZ_R1;
constexpr size_t WS_SX = WS_SC + SZ_R1;
constexpr size_t WS_GT = WS_SX + SZ_R1;
constexpr size_t WS_END = WS_GT + 2 * SZ_R1;
static_assert(WS_END <= 512 * MiB, "workspace map exceeds 512 MiB");
static_assert((size_t)RP * 32 * 4 <= 5 * MiB / 2, "dt");
constexpr int CW_BAR = 4096;
constexpr int LDS_BYTES = 163840;
constexpr int MISC_OFF = LDS_BYTES - 256;

__device__ __forceinline__ unsigned pk2(float lo, float hi) { unsigned r; asm("v_cvt_pk_bf16_f32 %0, %1, %2" : "=v"(r) : "v"(lo), "v"(hi)); return r; }
__device__ __forceinline__ float bf2f(bf16 v) { return __builtin_bit_cast(float, (unsigned)v << 16); }
__device__ __forceinline__ bf16 f2bf1(float f) { return (bf16)(pk2(f, 0.f) & 0xffffu); }
__device__ __forceinline__ float blo(unsigned u) { return __builtin_bit_cast(float, u << 16); }
__device__ __forceinline__ float bhi(unsigned u) { return __builtin_bit_cast(float, u & 0xffff0000u); }
__device__ __forceinline__ float siluf(float x) { return x * __builtin_amdgcn_rcpf(1.0f + __expf(-x)); }
__device__ __forceinline__ float wave_sum(float v) {
#pragma unroll
    for (int o = 1; o < 64; o <<= 1) v += __shfl_xor(v, o);
    return v;
}
#define XB_TMO      128
#define XB_XCNT(j)  (256  + 64 * (j))
#define XB_XSUB(j)  (1280 + 64 * (j))
#define XB_XGEN(j)  (2304 + 64 * (j))
#define XB_TOP      3328
#define XB_TOPGEN   3392
#define XCD_BAR_WORDS 3456
#define XB_SPIN_CAP (1u << 18)

__device__ __forceinline__ unsigned xb_ld(unsigned* p)              { return __hip_atomic_load(p, __ATOMIC_RELAXED, __HIP_MEMORY_SCOPE_AGENT); }
__device__ __forceinline__ unsigned xb_add(unsigned* p, unsigned v) { return __hip_atomic_fetch_add(p, v, __ATOMIC_RELAXED, __HIP_MEMORY_SCOPE_AGENT); }
__device__ __forceinline__ unsigned xb_xcc_id() { return (unsigned)__builtin_amdgcn_s_getreg((3 << 11) | 20) & 0xFu; }
#define XB_SPIN(cond, bar) do { unsigned _sp = 0; while (cond) { __builtin_amdgcn_s_sleep(1); \
    if ((++_sp & 255u) == 0u) { if (xb_ld(&(bar)[XB_TMO])) break; if (_sp > XB_SPIN_CAP) { atomicAdd(&(bar)[XB_TMO], 1u); break; } } } } while (0)

struct XcdBarrier {
    unsigned* bar; unsigned x;
    volatile LAS unsigned* st;
};

__device__ __forceinline__ XcdBarrier xcd_barrier_post(unsigned* bar, volatile LAS unsigned* st) {
    XcdBarrier b; b.bar = bar; b.x = xb_xcc_id(); b.st = st;
    if (threadIdx.x == 0) (void)xb_add(&bar[XB_XCNT(b.x)], 1u);
    return b;
}
__device__ __forceinline__ void xcd_barrier_complete(unsigned* bar, unsigned x, unsigned& nloc, unsigned& nx) {
    const unsigned G = gridDim.x * gridDim.y * gridDim.z;
    unsigned sum, cnt, mine, sp = 0u;
    for (;;) {
        sum = 0u; cnt = 0u; mine = 0u;
#pragma unroll
        for (unsigned j = 0; j < 16; ++j) { const unsigned c = xb_ld(&bar[XB_XCNT(j)]); sum += c; cnt += (c > 0u) ? 1u : 0u; mine = (j == x) ? c : mine; }
        if (sum == G) break;
        __builtin_amdgcn_s_sleep(1);
        if ((++sp & 255u) == 0u) { if (xb_ld(&bar[XB_TMO])) break; if (sp > XB_SPIN_CAP) { atomicAdd(&bar[XB_TMO], 1u); break; } }
    }
    nloc = mine > 0u ? mine : 1u; nx = cnt > 0u ? cnt : 1u;
}

__device__ __forceinline__ void xcd_barrier(const XcdBarrier& b) {
    asm volatile("s_waitcnt vmcnt(0)" ::: "memory");
    __syncthreads();
    if (threadIdx.x == 0) {
        unsigned* bar = b.bar;
        __builtin_amdgcn_s_waitcnt(0);
        unsigned nloc = b.st[0], nx = b.st[1];
        if (nloc == 0u) { xcd_barrier_complete(bar, b.x, nloc, nx); b.st[0] = nloc; b.st[1] = nx; }
        const unsigned old = xb_add(&bar[XB_XSUB(b.x)], 1u);
        const unsigned gen = old / nloc;
        if (old + 1u == (gen + 1u) * nloc) {
            __builtin_amdgcn_fence(__ATOMIC_RELEASE, "agent");
            asm volatile("s_waitcnt vmcnt(0)" ::: "memory");
            const unsigned og = xb_add(&bar[XB_TOP], 1u);
            const unsigned tg = og / nx;
            if (og + 1u == (tg + 1u) * nx) xb_add(&bar[XB_TOPGEN], 1u);
            else XB_SPIN(xb_ld(&bar[XB_TOPGEN]) == tg, bar);
            __builtin_amdgcn_fence(__ATOMIC_ACQUIRE, "agent");
            xb_add(&bar[XB_XGEN(b.x)], 1u);
            asm volatile("s_waitcnt vmcnt(0)" ::: "memory");
        } else {
            XB_SPIN(xb_ld(&bar[XB_XGEN(b.x)]) == gen, bar);
            __builtin_amdgcn_fence(__ATOMIC_ACQUIRE, "agent");
            asm volatile("s_waitcnt vmcnt(0)" ::: "memory");
        }
    }
    __syncthreads();
}


struct Ctx {
    LAS unsigned char* lds;
    int tid, lane, wave, vcu, G;
    float* out;
    unsigned char* ws;
};
struct Args { const float* in[20]; float* out; unsigned char* ws; int ph_lo, ph_hi; };
static_assert(sizeof(Args) == 22 * 8 + 8, "Args has no padding");
__device__ __forceinline__ int opq(int v) { asm volatile("" : "+v"(v)); return v; }
__device__ __forceinline__ unsigned char* opq_p(unsigned char* p) { asm volatile("" : "+s"(p)); return p; }
enum { I_X = 0, I_META, I_LNMIX, I_WIN, I_CONVW, I_CONVB, I_DTB, I_ALOG, I_D, I_NORM, I_WSSD, I_SCCW, I_WSC, I_WO, I_LNFFN, I_WQ, I_SK, I_PU, I_PV, I_LNF };

__device__ __forceinline__ void tr_item(const float* W, int ldw, int src0, int k0, bf16* WT, int K, int n0, LAS float* scr, int lane) {
#pragma unroll 8
    for (int i = 0; i < 32; ++i) { const int kk = 2 * i + (lane >> 5); scr[kk * 33 + (lane & 31)] = (src0 >= 0) ? W[(size_t)(k0 + kk) * ldw + src0 + (lane & 31)] : 0.f; }
    LDS_WAIT(); asm volatile("" ::: "memory");
    const int c = lane & 7;
#pragma unroll
    for (int j = 0; j < 4; ++j) { const int n = (lane >> 3) + 8 * j; const LAS float* s = scr + (8 * c) * 33 + n;
        v4u o; o.x = pk2(s[0 * 33], s[1 * 33]); o.y = pk2(s[2 * 33], s[3 * 33]); o.z = pk2(s[4 * 33], s[5 * 33]); o.w = pk2(s[6 * 33], s[7 * 33]);
        *(v4u*)(WT + (size_t)(n0 + n) * K + k0 + 8 * c) = o; }
    LDS_WAIT(); asm volatile("" ::: "memory");
}
__device__ __forceinline__ void cvt_item(const float* src, bf16* dst, int lane) {
#pragma unroll
    for (int i = 0; i < 8; ++i) { const f32x4 a = *(const f32x4*)(src + i * 512 + lane * 8), b = *(const f32x4*)(src + i * 512 + lane * 8 + 4);
        v4u o; o.x = pk2(a[0], a[1]); o.y = pk2(a[2], a[3]); o.z = pk2(b[0], b[1]); o.w = pk2(b[2], b[3]);
        *(v4u*)(dst + i * 512 + lane * 8) = o; }
}
template <bool SLICED> __device__ __forceinline__ void fp8_row(const float* src, unsigned char* dst, float* scale, int e, int lane) {
    f32x4 v[4]; float am = 0.f;
#pragma unroll
    for (int j = 0; j < 4; ++j) { v[j] = *(const f32x4*)(src + (size_t)e * 1024 + 4 * lane + 256 * j); am = fmaxf(am, fmaxf(fmaxf(fabsf(v[j][0]), fabsf(v[j][1])), fmaxf(fabsf(v[j][2]), fabsf(v[j][3])))); }
#pragma unroll
    for (int o = 1; o < 64; o <<= 1) am = fmaxf(am, __shfl_xor(am, o));
    const float s = (am > 0.f) ? am * (1.0f / 440.0f) : 1.0f, inv = 1.0f / s;
    if (lane == 0) scale[e] = s;
#pragma unroll
    for (int j = 0; j < 4; ++j) { int p = __builtin_amdgcn_cvt_pk_fp8_f32(v[j][0] * inv, v[j][1] * inv, 0, false); p = __builtin_amdgcn_cvt_pk_fp8_f32(v[j][2] * inv, v[j][3] * inv, p, true);
        const int c = 4 * lane + 256 * j;
        if (SLICED) *(int*)(dst + ((size_t)(c >> 7) * 16384 + e) * 128 + (c & 127)) = p;
        else *(int*)(dst + (size_t)e * 1024 + c) = p; }
}
__device__ __forceinline__ void rms_row_bf16(const float* xrow, const float* g, bf16* orow, int lane) {
    uint2* o8 = (uint2*)orow + lane;
    if (xrow == nullptr) {
#pragma unroll
        for (int j = 0; j < 4; ++j) o8[64 * j] = make_uint2(0u, 0u);
        return;
    }
    const f32x4* xr = (const f32x4*)xrow + lane; const f32x4* gr = (const f32x4*)g + lane;
    f32x4 v[4]; float s = 0.f;
#pragma unroll
    for (int j = 0; j < 4; ++j) { v[j] = xr[64 * j]; s += (v[j][0] * v[j][0] + v[j][1] * v[j][1]) + (v[j][2] * v[j][2] + v[j][3] * v[j][3]); }
    const float r = rsqrtf(wave_sum(s) * (1.f / 1024.f) + EPS);
#pragma unroll
    for (int j = 0; j < 4; ++j) { const f32x4 gg = gr[64 * j]; o8[64 * j] = make_uint2(pk2(v[j][0] * r * gg[0], v[j][1] * r * gg[1]), pk2(v[j][2] * r * gg[2], v[j][3] * r * gg[3])); }
}
__device__ __forceinline__ const float* u0_src(const Args& A, int sl, int r) {
    if (r < RS) return A.in[I_X] + ((size_t)(r >> 11) * SEQ + sl * SL + (r & (SL - 1))) * DM;
    const int l = r - RS;
    if (l >= 48 && l < 64) return A.in[I_META] + (size_t)(l - 48) * DM;
    return nullptr;
}
__device__ __forceinline__ void phase_prep(Ctx& C, const Args& A) {
    LAS float* scr = (LAS float*)(C.lds + C.wave * 16384);
    const int lane = opq(C.tid) & 63;
    const int gw = C.vcu * NWAVES + C.wave, NGW = C.G * NWAVES;
    unsigned char* ws = opq_p(C.ws);
    constexpr int N_WIN = 16 * 360, N_SSD = 32 * 32, N_SC = 16 * 32, N_WO = 16 * 32, N_WQ = 16 * 64, N_SKC = 64, N_EC = 16384, N_U0 = RP;
    constexpr int NITEMS = N_WIN + N_SSD + N_SC + N_WO + N_WQ + N_SKC + 2 * N_EC + N_U0;
    for (int it = gw; it < NITEMS; it += NGW) {
        int r = it;
        if (r < N_WIN) { const int kb = r / 360, nb = r % 360, n0 = nb * 32;
            const int src0 = (n0 < 6144) ? n0 : (n0 < 11264 ? n0 + 32 : (n0 < 11296 ? n0 - 11264 + 6144 : -1));
            tr_item(A.in[I_WIN], 11296, src0, kb * 64, (bf16*)(ws + WS_WIN), 1024, n0, scr, lane); continue; } r -= N_WIN;
        if (r < N_SSD) { const int kb = r / 32, nb = r % 32; tr_item(A.in[I_WSSD], 1024, nb * 32, kb * 64, (bf16*)(ws + WS_WSSD), 2048, nb * 32, scr, lane); continue; } r -= N_SSD;
        if (r < N_SC) { const int kb = r / 32, nb = r % 32; tr_item(A.in[I_WSC], 1024, nb * 32, kb * 64, (bf16*)(ws + WS_WSC), 1024, nb * 32, scr, lane); continue; } r -= N_SC;
        if (r < N_WO) { const int kb = r / 32, nb = r % 32; tr_item(A.in[I_WO], 1024, nb * 32, kb * 64, (bf16*)(ws + WS_WO), 1024, nb * 32, scr, lane); continue; } r -= N_WO;
        if (r < N_WQ) { const int kb = r / 64, nb = r % 64; tr_item(A.in[I_WQ], 2048, nb * 32, kb * 64, (bf16*)(ws + WS_WQ), 1024, nb * 32, scr, lane); continue; } r -= N_WQ;
        if (r < N_SKC) { cvt_item(A.in[I_SK] + (size_t)r * 4096, (bf16*)(ws + WS_SK) + (size_t)r * 4096, lane); continue; } r -= N_SKC;
        if (r < N_EC) { fp8_row<false>(A.in[I_PU], ws + WS_EU, (float*)(ws + WS_SU), r, lane); continue; } r -= N_EC;
        if (r < N_EC) { fp8_row<true>(A.in[I_PV], ws + WS_EV, (float*)(ws + WS_SV), r, lane); continue; } r -= N_EC;
        rms_row_bf16(u0_src(A, 0, r), A.in[I_LNMIX], (bf16*)(ws + WS_U0) + (size_t)r * DM, lane);
    }
}

constexpr int SC_RAWS = 328;
constexpr int SC_RAW = 0, SC_M = 44032, SC_CC = 53248, SC_BC = 70656, SC_BCT = 88064, SC_XST = 106496, SC_XDTT = 115712, SC_XDTET = 124928, SC_STB = 134144, SC_ACUM = 151552, SC_DTV = 152064;
constexpr int SC_S64 = 72, SC_S128 = 136;
static_assert(SC_DTV + 512 <= MISC_OFF, "scan LDS map");

__device__ __forceinline__ void phase_scan(Ctx& C, const Args& A, int sl) {
    const int tid = opq(C.tid), lane = tid & 63, wave = C.wave, fr = lane & 15, fq = lane >> 4;
    const int bh = C.vcu, b = bh >> 5, h = bh & 31, g = h >> 2;
    unsigned char* ws = opq_p(C.ws);
    bf16* XS = (bf16*)(ws + WS_XS); const bf16* BMp = (const bf16*)(ws + WS_BM); const bf16* CMp = (const bf16*)(ws + WS_CM); const float* DTp = (const float*)(ws + WS_DT);
    LAS bf16* RAW = (LAS bf16*)(C.lds + SC_RAW); LAS bf16* Mm = (LAS bf16*)(C.lds + SC_M); LAS bf16* CC = (LAS bf16*)(C.lds + SC_CC); LAS bf16* BC = (LAS bf16*)(C.lds + SC_BC);
    LAS bf16* BCT = (LAS bf16*)(C.lds + SC_BCT); LAS bf16* XST = (LAS bf16*)(C.lds + SC_XST); LAS bf16* XDTT = (LAS bf16*)(C.lds + SC_XDTT); LAS bf16* XDTET = (LAS bf16*)(C.lds + SC_XDTET);
    LAS bf16* STB = (LAS bf16*)(C.lds + SC_STB); LAS float* ACUM = (LAS float*)(C.lds + SC_ACUM); LAS float* DTV = (LAS float*)(C.lds + SC_DTV);
    const int chx = tid & 63, rbx = tid >> 6, chb = tid & 127, rbb = tid >> 7;
    const float* cw = A.in[I_CONVW]; const float* cb_ = A.in[I_CONVB];
    float wx[4], wB[4], wC[4];
    { const f32x4 t = *(const f32x4*)(cw + (size_t)(h * 64 + chx) * 4); wx[0] = t[0]; wx[1] = t[1]; wx[2] = t[2]; wx[3] = t[3]; }
    { const f32x4 t = *(const f32x4*)(cw + (size_t)(2048 + g * 128 + chb) * 4); wB[0] = t[0]; wB[1] = t[1]; wB[2] = t[2]; wB[3] = t[3]; }
    { const f32x4 t = *(const f32x4*)(cw + (size_t)(3072 + g * 128 + chb) * 4); wC[0] = t[0]; wC[1] = t[1]; wC[2] = t[2]; wC[3] = t[3]; }
    const float bx = cb_[h * 64 + chx], bB = cb_[2048 + g * 128 + chb], bC = cb_[3072 + g * 128 + chb];
    const float dtb = A.in[I_DTB][h], aneg = -__expf(A.in[I_ALOG][h]), dsk = A.in[I_D][h];
    const int tr = wave & 3, tc0 = (wave >> 2) * 2;
    const int tp = wave & 3, tn0 = (wave >> 2) * 4;
    f32x4 st[4];
    float* STATE = (float*)(ws + WS_STATE) + (size_t)bh * 64 * 128;
    bf16* HALO = (bf16*)(ws + WS_HALO) + (size_t)bh * 3 * 320;
    if (sl == 0) {
#pragma unroll
        for (int j = 0; j < 4; ++j) st[j] = (f32x4){0.f, 0.f, 0.f, 0.f};
        for (int i = tid; i < 3 * SC_RAWS; i += 512) RAW[i] = 0;
    } else {
#pragma unroll
        for (int j = 0; j < 4; ++j)
#pragma unroll
            for (int i = 0; i < 4; ++i) st[j][i] = STATE[(tp * 16 + fq * 4 + i) * 128 + (tn0 + j) * 16 + fr];
        for (int i = tid; i < 3 * 320; i += 512) RAW[(i / 320) * SC_RAWS + (i % 320)] = HALO[i];
    }
#pragma unroll
    for (int j = 0; j < 4; ++j)
#pragma unroll
        for (int i = 0; i < 4; ++i) STB[(tp * 16 + fq * 4 + i) * SC_S128 + (tn0 + j) * 16 + fr] = f2bf1(st[j][i]);
    const int c_begin = (sl == 0) ? -1 : 0;
    v4u pre[5]; float dtn = 0.f;
#define ROW_BASE(ci) ((ci) < 0 ? RS : b * SL + (ci) * 64)
#define SCAN_LOAD(ci) do { const int rb_ = ROW_BASE(ci); \
        _Pragma("unroll") for (int i_ = 0; i_ < 5; ++i_) { const int p_ = tid + 512 * i_, r_ = p_ / 40, pc_ = p_ % 40; const size_t gr_ = (size_t)(rb_ + r_); \
            const bf16* src_ = (pc_ < 8) ? (XS + gr_ * 2048 + h * 64 + pc_ * 8) : (pc_ < 24) ? (BMp + gr_ * 1024 + g * 128 + (pc_ - 8) * 8) : (CMp + gr_ * 1024 + g * 128 + (pc_ - 24) * 8); \
            pre[i_] = *(const v4u*)src_; } \
        if (wave == 0) dtn = DTp[(size_t)(rb_ + lane) * 32 + h]; } while (0)
#define SCAN_STORE_RAW() do { _Pragma("unroll") for (int i_ = 0; i_ < 5; ++i_) { const int p_ = tid + 512 * i_, r_ = p_ / 40, pc_ = p_ % 40; \
            *(LAS v4u*)(RAW + (3 + r_) * SC_RAWS + pc_ * 8) = pre[i_]; } } while (0)
#define SCAN_DT(par) do { if (wave == 0) { const float x_ = dtn + dtb; const float dv_ = (x_ > 20.f) ? x_ : log1pf(__expf(x_)); float a_ = aneg * dv_; \
            _Pragma("unroll") for (int o_ = 1; o_ < 64; o_ <<= 1) { const float t_ = __shfl_up(a_, o_); if (lane >= o_) a_ += t_; } \
            ACUM[(par) * 64 + lane] = a_; DTV[(par) * 64 + lane] = dv_; } } while (0)
    SCAN_LOAD(c_begin);
    SCAN_STORE_RAW();
    SCAN_DT(0);
    __syncthreads();
    int par = 0;
    for (int ci = c_begin; ci < SL / 64; ++ci, par ^= 1) {
        const bool has_next = (ci + 1 < SL / 64);
        const int lmask = (ci < 0) ? 48 : 0;
        const LAS float* AC = ACUM + par * 64; const LAS float* DV = DTV + par * 64;
        const float aend = AC[63];
        {
            float r[11];
#pragma unroll
            for (int i = 0; i < 11; ++i) r[i] = bf2f(RAW[(rbx * 8 + i) * SC_RAWS + chx]);
            float xv[8], xd[8], xe[8];
#pragma unroll
            for (int j = 0; j < 8; ++j) { const int l = rbx * 8 + j; float a = bx + wx[0] * r[j] + wx[1] * r[j + 1] + wx[2] * r[j + 2] + wx[3] * r[j + 3];
                a = (l >= lmask) ? siluf(a) : 0.f; xv[j] = a; xd[j] = a * DV[l]; xe[j] = xd[j] * __expf(aend - AC[l]); }
            v4u o;
            o.x = pk2(xv[0], xv[1]); o.y = pk2(xv[2], xv[3]); o.z = pk2(xv[4], xv[5]); o.w = pk2(xv[6], xv[7]); *(LAS v4u*)(XST + chx * SC_S64 + rbx * 8) = o;
            o.x = pk2(xd[0], xd[1]); o.y = pk2(xd[2], xd[3]); o.z = pk2(xd[4], xd[5]); o.w = pk2(xd[6], xd[7]); *(LAS v4u*)(XDTT + chx * SC_S64 + rbx * 8) = o;
            o.x = pk2(xe[0], xe[1]); o.y = pk2(xe[2], xe[3]); o.z = pk2(xe[4], xe[5]); o.w = pk2(xe[6], xe[7]); *(LAS v4u*)(XDTET + chx * SC_S64 + rbx * 8) = o;
        }
        __builtin_amdgcn_sched_barrier(0);
        {
            float r[19];
#pragma unroll
            for (int i = 0; i < 19; ++i) r[i] = bf2f(RAW[(rbb * 16 + i) * SC_RAWS + 64 + chb]);
            float v[16];
#pragma unroll
            for (int j = 0; j < 16; ++j) { const int l = rbb * 16 + j; float a = bB + wB[0] * r[j] + wB[1] * r[j + 1] + wB[2] * r[j + 2] + wB[3] * r[j + 3];
                a = (l >= lmask) ? siluf(a) : 0.f; v[j] = a; BC[l * SC_S128 + chb] = f2bf1(a); }
            v4u o;
            o.x = pk2(v[0], v[1]); o.y = pk2(v[2], v[3]); o.z = pk2(v[4], v[5]); o.w = pk2(v[6], v[7]); *(LAS v4u*)(BCT + chb * SC_S64 + rbb * 16) = o;
            o.x = pk2(v[8], v[9]); o.y = pk2(v[10], v[11]); o.z = pk2(v[12], v[13]); o.w = pk2(v[14], v[15]); *(LAS v4u*)(BCT + chb * SC_S64 + rbb * 16 + 8) = o;
        }
        __builtin_amdgcn_sched_barrier(0);
        {
            float r[19];
#pragma unroll
            for (int i = 0; i < 19; ++i) r[i] = bf2f(RAW[(rbb * 16 + i) * SC_RAWS + 192 + chb]);
#pragma unroll
            for (int j = 0; j < 16; ++j) { const int l = rbb * 16 + j; float a = bC + wC[0] * r[j] + wC[1] * r[j + 1] + wC[2] * r[j + 2] + wC[3] * r[j + 3];
                a = (l >= lmask) ? siluf(a) : 0.f; CC[l * SC_S128 + chb] = f2bf1(a); }
        }
        __syncthreads();
        if (has_next) SCAN_LOAD(ci + 1);
        if (tid < 123) { const v4u t = *(LAS v4u*)((LAS unsigned char*)RAW + 64 * SC_RAWS * 2 + tid * 16); *(LAS v4u*)((LAS unsigned char*)RAW + tid * 16) = t; }
        bf16x8 ca[4];
#pragma unroll
        for (int kk = 0; kk < 4; ++kk) ca[kk] = *(LAS bf16x8*)(CC + (tr * 16 + fr) * SC_S128 + kk * 32 + fq * 8);
        f32x4 yacc[2];
#pragma unroll
        for (int t = 0; t < 2; ++t) {
            const int tc = tc0 + t;
            f32x4 a1 = {0.f, 0.f, 0.f, 0.f}, a2 = {0.f, 0.f, 0.f, 0.f};
#pragma unroll
            for (int kk = 0; kk < 4; ++kk) {
                const bf16x8 bb = *(LAS bf16x8*)(BC + (tc * 16 + fr) * SC_S128 + kk * 32 + fq * 8);
                const bf16x8 sb = *(LAS bf16x8*)(STB + (tc * 16 + fr) * SC_S128 + kk * 32 + fq * 8);
                a1 = __builtin_amdgcn_mfma_f32_16x16x32_bf16(ca[kk], bb, a1, 0, 0, 0);
                a2 = __builtin_amdgcn_mfma_f32_16x16x32_bf16(ca[kk], sb, a2, 0, 0, 0);
            }
            const int s = tc * 16 + fr; const float as = AC[s];
#pragma unroll
            for (int i = 0; i < 4; ++i) { const int l = tr * 16 + fq * 4 + i; const float al = AC[l];
                const float mv = (l >= s) ? a1[i] * __expf(al - as) : 0.f;
                Mm[l * SC_S64 + s] = f2bf1(mv);
                yacc[t][i] = a2[i] * __expf(al); }
        }
        {
            const float dec = __expf(aend);
            bf16x8 xa[2];
#pragma unroll
            for (int kk = 0; kk < 2; ++kk) xa[kk] = *(LAS bf16x8*)(XDTET + (tp * 16 + fr) * SC_S64 + kk * 32 + fq * 8);
#pragma unroll
            for (int j = 0; j < 4; ++j) { st[j] = st[j] * dec;
#pragma unroll
                for (int kk = 0; kk < 2; ++kk) { const bf16x8 bb = *(LAS bf16x8*)(BCT + ((tn0 + j) * 16 + fr) * SC_S64 + kk * 32 + fq * 8);
                    st[j] = __builtin_amdgcn_mfma_f32_16x16x32_bf16(xa[kk], bb, st[j], 0, 0, 0); } }
        }
        __syncthreads();
#pragma unroll
        for (int j = 0; j < 4; ++j)
#pragma unroll
            for (int i = 0; i < 4; ++i) STB[(tp * 16 + fq * 4 + i) * SC_S128 + (tn0 + j) * 16 + fr] = f2bf1(st[j][i]);
        {
            bf16x8 ma[2];
#pragma unroll
            for (int kk = 0; kk < 2; ++kk) ma[kk] = *(LAS bf16x8*)(Mm + (tr * 16 + fr) * SC_S64 + kk * 32 + fq * 8);
            const int rb0 = ROW_BASE(ci);
#pragma unroll
            for (int t = 0; t < 2; ++t) { const int p = (tc0 + t) * 16 + fr;
#pragma unroll
                for (int kk = 0; kk < 2; ++kk) { const bf16x8 xb = *(LAS bf16x8*)(XDTT + p * SC_S64 + kk * 32 + fq * 8);
                    yacc[t] = __builtin_amdgcn_mfma_f32_16x16x32_bf16(ma[kk], xb, yacc[t], 0, 0, 0); }
                if (ci >= 0) {
#pragma unroll
                    for (int i = 0; i < 4; ++i) { const int l = tr * 16 + fq * 4 + i; const float yv = yacc[t][i] + dsk * bf2f(XST[p * SC_S64 + l]);
                        XS[(size_t)(rb0 + l) * 2048 + h * 64 + p] = f2bf1(yv); }
                }
            }
        }
        if (has_next) { SCAN_STORE_RAW(); SCAN_DT(par ^ 1); }
        __syncthreads();
    }
    if (sl + 1 < NSLICE) {
#pragma unroll
        for (int j = 0; j < 4; ++j)
#pragma unroll
            for (int i = 0; i < 4; ++i) STATE[(tp * 16 + fq * 4 + i) * 128 + (tn0 + j) * 16 + fr] = st[j][i];
        for (int i = tid; i < 3 * 320; i += 512) HALO[i] = RAW[(i / 320) * SC_RAWS + (i % 320)];
    }
#undef SCAN_LOAD
#undef ROW_BASE
#undef SCAN_STORE_RAW
#undef SCAN_DT
}

__device__ __forceinline__ void phase_elem(Ctx& C, const Args& A, int sl) {
    const int gw = C.vcu * NWAVES + C.wave, lane = opq(C.tid) & 63;
    unsigned char* ws = opq_p(C.ws);
    bf16* XS = (bf16*)(ws + WS_XS); const bf16* Zb = (const bf16*)(ws + WS_Z);
    {
        const float* ng = A.in[I_NORM];
        f32x4 gq[4][2];
#pragma unroll
        for (int j = 0; j < 4; ++j) { gq[j][0] = *(const f32x4*)(ng + 8 * lane + 512 * j); gq[j][1] = *(const f32x4*)(ng + 8 * lane + 512 * j + 4); }
        for (int rr = 0; rr < 8; ++rr) {
            const size_t r = (size_t)gw * 8 + rr;
            v4u yv[4], zv[4];
#pragma unroll
            for (int j = 0; j < 4; ++j) { yv[j] = *(const v4u*)(XS + r * 2048 + 8 * lane + 512 * j); zv[j] = *(const v4u*)(Zb + r * 2048 + 8 * lane + 512 * j); }
#pragma unroll
            for (int j = 0; j < 4; ++j) {
                float v[8];
#pragma unroll
                for (int q = 0; q < 4; ++q) { v[2 * q] = blo(yv[j][q]) * siluf(blo(zv[j][q])); v[2 * q + 1] = bhi(yv[j][q]) * siluf(bhi(zv[j][q])); }
                float ss = 0.f;
#pragma unroll
                for (int q = 0; q < 8; ++q) ss += v[q] * v[q];
#pragma unroll
                for (int o = 1; o < 32; o <<= 1) ss += __shfl_xor(ss, o);
                const float rs = rsqrtf(ss * (1.f / 256.f) + EPS);
                v4u o4; o4.x = pk2(v[0] * rs * gq[j][0][0], v[1] * rs * gq[j][0][1]); o4.y = pk2(v[2] * rs * gq[j][0][2], v[3] * rs * gq[j][0][3]);
                o4.z = pk2(v[4] * rs * gq[j][1][0], v[5] * rs * gq[j][1][1]); o4.w = pk2(v[6] * rs * gq[j][1][2], v[7] * rs * gq[j][1][3]);
                *(v4u*)(XS + r * 2048 + 8 * lane + 512 * j) = o4;
            }
        }
    }
    {
        const bf16* SBp = (const bf16*)(ws + WS_SB); const bf16* SCp = (const bf16*)(ws + WS_SC); const bf16* SXp = (const bf16*)(ws + WS_SX);
        bf16* SCV = (bf16*)(ws + WS_U0); float* SCH = (float*)(ws + WS_SCH);
        const float* w3 = A.in[I_SCCW];
        const int r0 = gw * 8, b = r0 >> 11, s0 = r0 & (SL - 1);
#pragma unroll
        for (int j = 0; j < 2; ++j) {
            const int ch0 = 8 * lane + 512 * j;
            float w0[8], w1[8], w2[8];
#pragma unroll
            for (int q = 0; q < 8; ++q) { w0[q] = w3[(ch0 + q) * 3 + 0]; w1[q] = w3[(ch0 + q) * 3 + 1]; w2[q] = w3[(ch0 + q) * 3 + 2]; }
            float pm2[8], pm1[8];
            if (s0 == 0 && sl > 0) {
#pragma unroll
                for (int q = 0; q < 8; ++q) { pm2[q] = SCH[(b * 2 + 0) * 1024 + ch0 + q]; pm1[q] = SCH[(b * 2 + 1) * 1024 + ch0 + q]; }
            } else {
                const size_t ra = (s0 == 0) ? (size_t)(RS + 62) : (size_t)(r0 - 2), rb = (s0 == 0) ? (size_t)(RS + 63) : (size_t)(r0 - 1);
                const v4u c2 = *(const v4u*)(SCp + ra * 1024 + ch0), x2 = *(const v4u*)(SXp + ra * 1024 + ch0), c1 = *(const v4u*)(SCp + rb * 1024 + ch0), x1 = *(const v4u*)(SXp + rb * 1024 + ch0);
#pragma unroll
                for (int q = 0; q < 4; ++q) { pm2[2 * q] = blo(c2[q]) * blo(x2[q]); pm2[2 * q + 1] = bhi(c2[q]) * bhi(x2[q]); pm1[2 * q] = blo(c1[q]) * blo(x1[q]); pm1[2 * q + 1] = bhi(c1[q]) * bhi(x1[q]); }
            }
            for (int rr = 0; rr < 8; ++rr) {
                const size_t r = (size_t)r0 + rr;
                const v4u cv = *(const v4u*)(SCp + r * 1024 + ch0), xv = *(const v4u*)(SXp + r * 1024 + ch0), bv = *(const v4u*)(SBp + r * 1024 + ch0);
                float p0[8], o[8];
#pragma unroll
                for (int q = 0; q < 4; ++q) { p0[2 * q] = blo(cv[q]) * blo(xv[q]); p0[2 * q + 1] = bhi(cv[q]) * bhi(xv[q]); }
#pragma unroll
                for (int q = 0; q < 4; ++q) { o[2 * q] = blo(bv[q]) * (w0[2 * q] * pm2[2 * q] + w1[2 * q] * pm1[2 * q] + w2[2 * q] * p0[2 * q]);
                    o[2 * q + 1] = bhi(bv[q]) * (w0[2 * q + 1] * pm2[2 * q + 1] + w1[2 * q + 1] * pm1[2 * q + 1] + w2[2 * q + 1] * p0[2 * q + 1]); }
                v4u o4; o4.x = pk2(o[0], o[1]); o4.y = pk2(o[2], o[3]); o4.z = pk2(o[4], o[5]); o4.w = pk2(o[6], o[7]);
                *(v4u*)(SCV + r * 1024 + ch0) = o4;
#pragma unroll
                for (int q = 0; q < 8; ++q) { pm2[q] = pm1[q]; pm1[q] = p0[q]; }
            }
            if (sl + 1 < NSLICE && s0 == SL - 8) {
#pragma unroll
                for (int q = 0; q < 8; ++q) { SCH[(b * 2 + 0) * 1024 + ch0 + q] = pm2[q]; SCH[(b * 2 + 1) * 1024 + ch0 + q] = pm1[q]; }
            }
        }
    }
}

__device__ __forceinline__ void phase_norm(Ctx& C, const Args& A, int sl) {
    const int gw = C.vcu * NWAVES + C.wave, NGW = C.G * NWAVES, lane = opq(C.tid) & 63;
    unsigned char* ws = opq_p(C.ws);
    const float* H1 = (const float*)(ws + WS_Z); bf16* U1 = (bf16*)(ws + WS_BM);
    for (int r = gw; r < RS; r += NGW) rms_row_bf16(H1 + (size_t)r * DM, A.in[I_LNFFN], U1 + (size_t)r * DM, lane);
    if (sl + 1 < NSLICE) for (int r = gw; r < RS; r += NGW) rms_row_bf16(u0_src(A, sl + 1, r), A.in[I_LNMIX], (bf16*)(ws + WS_U0) + (size_t)r * DM, lane);
}

__device__ __forceinline__ int med3i(int a, int b, int c) { int r; asm("v_med3_i32 %0, %1, %2, %3" : "=v"(r) : "v"(a), "v"(b), "v"(c)); return r; }
__device__ __forceinline__ int ord_key(float f) { int k = __builtin_bit_cast(int, f); return k ^ ((k >> 31) & 0x7fffffff); }
__device__ __forceinline__ float ord_val(int k) { return __builtin_bit_cast(float, k ^ ((k >> 31) & 0x7fffffff)); }
#define TK_INSERT(L, x) do { const int x_ = (x); \
    L[15] = med3i(L[14], x_, L[15]); L[14] = med3i(L[13], x_, L[14]); L[13] = med3i(L[12], x_, L[13]); L[12] = med3i(L[11], x_, L[12]); \
    L[11] = med3i(L[10], x_, L[11]); L[10] = med3i(L[9], x_, L[10]); L[9] = med3i(L[8], x_, L[9]); L[8] = med3i(L[7], x_, L[8]); \
    L[7] = med3i(L[6], x_, L[7]); L[6] = med3i(L[5], x_, L[6]); L[5] = med3i(L[4], x_, L[5]); L[4] = med3i(L[3], x_, L[4]); \
    L[3] = med3i(L[2], x_, L[3]); L[2] = med3i(L[1], x_, L[2]); L[1] = med3i(L[0], x_, L[1]); L[0] = max(L[0], x_); } while (0)
constexpr int TK_QS = 264;

__device__ __forceinline__ void phase_topk(Ctx& C) {
    const int lane = opq(C.tid) & 63;
    const int gw = C.vcu * NWAVES + C.wave, NGW = C.G * NWAVES, r32 = lane & 31, hf = lane >> 5;
    unsigned char* ws = opq_p(C.ws);
    const bf16* Q = (const bf16*)(ws + WS_GT); const bf16* SK = (const bf16*)(ws + WS_SK);
    int* EIDX = (int*)(ws + WS_SB); float* GWV = (float*)(ws + WS_SB + 8 * MiB); float* SUW = (float*)(ws + WS_SB + 16 * MiB);
    const float* SU = (const float*)(ws + WS_SU); const float* SV = (const float*)(ws + WS_SV);
    LAS bf16* Qs = (LAS bf16*)(C.lds + C.wave * 17408);
    for (int task = gw; task < (RS / 32) * 8; task += NGW) {
        const int tb = task >> 3, hh = task & 7, r0 = tb * 32;
#pragma unroll
        for (int i = 0; i < 16; ++i) { const int piece = i * 64 + lane, row = piece >> 5, c16 = piece & 31;
            *(LAS v4u*)(Qs + row * TK_QS + c16 * 8) = *(const v4u*)(Q + (size_t)(r0 + row) * 2048 + hh * 256 + c16 * 8); }
        LDS_WAIT(); asm volatile("" ::: "memory");
        int LA[16], LB[16];
#pragma unroll
        for (int j = 0; j < 2; ++j) {
            f32x16 acc[4];
#pragma unroll
            for (int kb = 0; kb < 4; ++kb)
#pragma unroll
                for (int q = 0; q < 16; ++q) acc[kb][q] = 0.f;
            const bf16* skp = SK + (size_t)((hh * 2 + j) * 128 + r32) * 128 + hf * 8;
#pragma unroll 2
            for (int kk = 0; kk < 8; ++kk) {
                const bf16x8 bq = *(LAS bf16x8*)(Qs + r32 * TK_QS + j * 128 + kk * 16 + hf * 8);
#pragma unroll
                for (int kb = 0; kb < 4; ++kb) { const bf16x8 ak = *(const bf16x8*)(skp + (size_t)kb * 32 * 128 + kk * 16);
                    acc[kb] = __builtin_amdgcn_mfma_f32_32x32x16_bf16(ak, bq, acc[kb], 0, 0, 0); }
            }
            int L[16];
#pragma unroll
            for (int q = 0; q < 16; ++q) L[q] = (int)0x80000000;
#pragma unroll
            for (int kb = 0; kb < 4; ++kb)
#pragma unroll
                for (int q = 0; q < 16; ++q) { const int key = kb * 32 + (q & 3) + 8 * (q >> 2) + 4 * hf;
                    const int x = (ord_key(acc[kb][q]) & ~127) | (127 - key); TK_INSERT(L, x); }
            int T[16];
#pragma unroll
            for (int q = 0; q < 16; ++q) T[q] = __shfl_xor(L[q], 32);
#pragma unroll
            for (int q = 0; q < 16; ++q) TK_INSERT(L, T[q]);
            if (j == 0) {
#pragma unroll
                for (int q = 0; q < 16; ++q) LA[q] = L[q];
            } else {
#pragma unroll
                for (int q = 0; q < 16; ++q) LB[q] = L[q];
            }
        }
        float av[16], bv[16]; unsigned pa[4] = {0u, 0u, 0u, 0u}, pb[4] = {0u, 0u, 0u, 0u};
#pragma unroll
        for (int q = 0; q < 16; ++q) { av[q] = ord_val(LA[q] & ~127); bv[q] = ord_val(LB[q] & ~127);
            pa[q >> 2] |= (unsigned)(127 - (LA[q] & 127)) << (8 * (q & 3)); pb[q >> 2] |= (unsigned)(127 - (LB[q] & 127)) << (8 * (q & 3)); }
        int LC[16];
#pragma unroll
        for (int q = 0; q < 16; ++q) LC[q] = (int)0x80000000;
#pragma unroll
        for (int i = 0; i < 16; ++i)
#pragma unroll
            for (int jj = 0; jj < 16; ++jj)
                if ((i + 1) * (jj + 1) <= 16) { const int x = (ord_key(av[i] + bv[jj]) & ~255) | (255 - (i * 16 + jj)); TK_INSERT(LC, x); }
        float cs[16], es[16], esum = 0.f; int ei[16];
#pragma unroll
        for (int q = 0; q < 16; ++q) { cs[q] = ord_val(LC[q] & ~255); const int ci = 255 - (LC[q] & 255), i = ci >> 4, jj = ci & 15;
            const unsigned wa = (i < 8) ? ((i < 4) ? pa[0] : pa[1]) : ((i < 12) ? pa[2] : pa[3]);
            const unsigned wb = (jj < 8) ? ((jj < 4) ? pb[0] : pb[1]) : ((jj < 12) ? pb[2] : pb[3]);
            const int i1 = (wa >> (8 * (i & 3))) & 255, i2 = (wb >> (8 * (jj & 3))) & 255;
            ei[q] = i1 * 128 + i2; }
#pragma unroll
        for (int q = 0; q < 16; ++q) { es[q] = __expf(cs[q] - cs[0]); esum += es[q]; }
        const float rinv = 1.0f / esum;
        if (hf == 0) {
            int* ep = EIDX + (size_t)(r0 + r32) * 128 + hh * 16; float* gp = GWV + (size_t)(r0 + r32) * 128 + hh * 16; float* sp = SUW + (size_t)(r0 + r32) * 128 + hh * 16;
            float su_[16], sv_[16];
#pragma unroll
            for (int q = 0; q < 16; ++q) { su_[q] = SU[ei[q]]; sv_[q] = SV[ei[q]]; }
#pragma unroll
            for (int q = 0; q < 4; ++q) { *(int4*)(ep + 4 * q) = make_int4(ei[4 * q], ei[4 * q + 1], ei[4 * q + 2], ei[4 * q + 3]);
                *(f32x4*)(gp + 4 * q) = (f32x4){es[4 * q] * rinv * sv_[4 * q], es[4 * q + 1] * rinv * sv_[4 * q + 1], es[4 * q + 2] * rinv * sv_[4 * q + 2], es[4 * q + 3] * rinv * sv_[4 * q + 3]};
                *(f32x4*)(sp + 4 * q) = (f32x4){su_[4 * q], su_[4 * q + 1], su_[4 * q + 2], su_[4 * q + 3]}; }
        }
        LDS_WAIT(); asm volatile("" ::: "memory");
    }
}

typedef float f32x2v __attribute__((ext_vector_type(2)));
__device__ __forceinline__ void fp8x16_to_f32(const v4u r, float (&f)[16]) {
#pragma unroll
    for (int q = 0; q < 4; ++q) { const f32x2v lo = __builtin_amdgcn_cvt_pk_f32_fp8((int)r[q], false), hi = __builtin_amdgcn_cvt_pk_f32_fp8((int)r[q], true);
        f[4 * q] = lo[0]; f[4 * q + 1] = lo[1]; f[4 * q + 2] = hi[0]; f[4 * q + 3] = hi[1]; }
}
__device__ __forceinline__ float gelu_erf(float x) { return 0.5f * x * (1.0f + erff(x * 0.70710678118654752f)); }

__device__ __forceinline__ void phase_peer_dots(Ctx& C) {
    const int lane = opq(C.tid) & 63;
    const int x = C.vcu >> 5, wv = (C.vcu & 31) * NWAVES + C.wave;
    unsigned char* ws = opq_p(C.ws);
    const bf16* U1 = (const bf16*)(ws + WS_BM); const int* EIDX = (const int*)(ws + WS_SB); const float* SUW = (const float*)(ws + WS_SB + 16 * MiB); float* DD = (float*)(ws + WS_SB + 24 * MiB);
    const unsigned char* EU8 = ws + WS_EU;
    for (int t = wv; t < RS; t += 256) {
        const int e0 = EIDX[(size_t)t * 128 + lane], e1 = EIDX[(size_t)t * 128 + 64 + lane];
        const v4u ua = *(const v4u*)(U1 + (size_t)t * DM + 16 * lane), ub = *(const v4u*)(U1 + (size_t)t * DM + 16 * lane + 8);
        float uf[16];
#pragma unroll
        for (int q = 0; q < 4; ++q) { uf[2 * q] = blo(ua[q]); uf[2 * q + 1] = bhi(ua[q]); uf[8 + 2 * q] = blo(ub[q]); uf[8 + 2 * q + 1] = bhi(ub[q]); }
        unsigned long long m0 = __ballot((e0 >> 11) == x), m1 = __ballot((e1 >> 11) == x);
        while ((m0 | m1) != 0ull) {
            int es[8]; int slotv = 0, nb = 0, le = 0;
#pragma unroll
            for (int k = 0; k < 8; ++k) {
                if ((m0 | m1) != 0ull) {
                    int slot;
                    if (m0 != 0ull) { const int bpos = __builtin_ctzll(m0); m0 &= m0 - 1ull; slot = bpos; le = __builtin_amdgcn_readlane(e0, bpos); }
                    else { const int bpos = __builtin_ctzll(m1); m1 &= m1 - 1ull; slot = 64 + bpos; le = __builtin_amdgcn_readlane(e1, bpos); }
                    slotv = (lane == k) ? slot : slotv; nb = k + 1;
                }
                es[k] = le;
            }
            v4u rows[8];
#pragma unroll
            for (int k = 0; k < 8; ++k) rows[k] = *(const v4u*)(EU8 + (size_t)es[k] * 1024 + 16 * lane);
            float p[8];
#pragma unroll
            for (int k = 0; k < 8; ++k) { float f[16]; fp8x16_to_f32(rows[k], f); float s0 = 0.f, s1 = 0.f;
#pragma unroll
                for (int q = 0; q < 8; ++q) { s0 = fmaf(f[2 * q], uf[2 * q], s0); s1 = fmaf(f[2 * q + 1], uf[2 * q + 1], s1); }
                p[k] = s0 + s1; }
            float q4[4], q2[2], q1;
            { const bool bt = lane & 1;
#pragma unroll
              for (int m = 0; m < 4; ++m) { const float keep = bt ? p[2 * m + 1] : p[2 * m], send = bt ? p[2 * m] : p[2 * m + 1]; q4[m] = keep + __shfl_xor(send, 1); } }
            { const bool bt = lane & 2;
#pragma unroll
              for (int m = 0; m < 2; ++m) { const float keep = bt ? q4[2 * m + 1] : q4[2 * m], send = bt ? q4[2 * m] : q4[2 * m + 1]; q2[m] = keep + __shfl_xor(send, 2); } }
            { const bool bt = lane & 4; const float keep = bt ? q2[1] : q2[0], send = bt ? q2[0] : q2[1]; q1 = keep + __shfl_xor(send, 4); }
            q1 += __shfl_xor(q1, 8); q1 += __shfl_xor(q1, 16); q1 += __shfl_xor(q1, 32);
            if (lane < nb) DD[(size_t)t * 128 + slotv] = q1 * SUW[(size_t)t * 128 + slotv];
        }
    }
}

__device__ __forceinline__ void phase_peer_out(Ctx& C) {
    const int lane = opq(C.tid) & 63, rg = lane >> 3, ck = lane & 7;
    const int x = C.vcu >> 5, wv = (C.vcu & 31) * NWAVES + C.wave;
    unsigned char* ws = opq_p(C.ws);
    const int* EIDX = (const int*)(ws + WS_SB); const float* GWV = (const float*)(ws + WS_SB + 8 * MiB); const float* DD = (const float*)(ws + WS_SB + 24 * MiB);
    float* FF = (float*)(ws + WS_XS);
    const unsigned char* EV8 = ws + WS_EV + (size_t)x * 16384 * 128 + ck * 16;
    LAS float* Wl = (LAS float*)(C.lds + C.wave * 1024); LAS int* El = (LAS int*)(C.lds + C.wave * 1024 + 512);
    for (int t = wv; t < RS; t += 256) {
        const float d0 = DD[(size_t)t * 128 + lane], d1 = DD[(size_t)t * 128 + 64 + lane], g0 = GWV[(size_t)t * 128 + lane], g1 = GWV[(size_t)t * 128 + 64 + lane];
        const int e0 = EIDX[(size_t)t * 128 + lane], e1 = EIDX[(size_t)t * 128 + 64 + lane];
        Wl[lane] = g0 * gelu_erf(d0); Wl[64 + lane] = g1 * gelu_erf(d1); El[lane] = e0; El[64 + lane] = e1;
        LDS_WAIT(); asm volatile("" ::: "memory");
        int ee[16]; float ww[16];
#pragma unroll
        for (int q = 0; q < 4; ++q) { typedef int v4i_ __attribute__((ext_vector_type(4))); const v4i_ ev = *(LAS v4i_*)(El + rg * 16 + 4 * q); const f32x4 wv4 = *(LAS f32x4*)(Wl + rg * 16 + 4 * q);
            ee[4 * q] = ev[0]; ee[4 * q + 1] = ev[1]; ee[4 * q + 2] = ev[2]; ee[4 * q + 3] = ev[3]; ww[4 * q] = wv4[0]; ww[4 * q + 1] = wv4[1]; ww[4 * q + 2] = wv4[2]; ww[4 * q + 3] = wv4[3]; }
        v4u rows[16];
#pragma unroll
        for (int i = 0; i < 16; ++i) rows[i] = *(const v4u*)(EV8 + (size_t)ee[i] * 128);
        float acc[16];
#pragma unroll
        for (int q = 0; q < 16; ++q) acc[q] = 0.f;
#pragma unroll
        for (int i = 0; i < 16; ++i) { float f[16]; fp8x16_to_f32(rows[i], f);
#pragma unroll
            for (int q = 0; q < 16; ++q) acc[q] = fmaf(ww[i], f[q], acc[q]); }
        float q8[8], q4[4], q2[2];
        { const bool bt = lane & 8;
#pragma unroll
          for (int m = 0; m < 8; ++m) { const float keep = bt ? acc[2 * m + 1] : acc[2 * m], send = bt ? acc[2 * m] : acc[2 * m + 1]; q8[m] = keep + __shfl_xor(send, 8); } }
        { const bool bt = lane & 16;
#pragma unroll
          for (int m = 0; m < 4; ++m) { const float keep = bt ? q8[2 * m + 1] : q8[2 * m], send = bt ? q8[2 * m] : q8[2 * m + 1]; q4[m] = keep + __shfl_xor(send, 16); } }
        { const bool bt = lane & 32;
#pragma unroll
          for (int m = 0; m < 2; ++m) { const float keep = bt ? q4[2 * m + 1] : q4[2 * m], send = bt ? q4[2 * m] : q4[2 * m + 1]; q2[m] = keep + __shfl_xor(send, 32); } }
        float* fp = FF + (size_t)t * DM + 128 * x + ck * 16 + rg;
        fp[0] = q2[0]; fp[8] = q2[1];
        LDS_WAIT(); asm volatile("" ::: "memory");
    }
}

__device__ __forceinline__ void phase_final(Ctx& C, const Args& A, int sl) {
    const int gw = C.vcu * NWAVES + C.wave, NGW = C.G * NWAVES, lane = opq(C.tid) & 63;
    unsigned char* ws = opq_p(C.ws);
    const float* H1 = (const float*)(ws + WS_Z); const float* FF = (const float*)(ws + WS_XS);
    const f32x4* gr = (const f32x4*)A.in[I_LNF] + lane;
    for (int r = gw; r < RS; r += NGW) {
        const f32x4* hp = (const f32x4*)(H1 + (size_t)r * DM) + lane; const f32x4* fp = (const f32x4*)(FF + (size_t)r * DM) + lane;
        f32x4 v[4]; float s = 0.f;
#pragma unroll
        for (int j = 0; j < 4; ++j) { v[j] = hp[64 * j] + fp[64 * j]; s += (v[j][0] * v[j][0] + v[j][1] * v[j][1]) + (v[j][2] * v[j][2] + v[j][3] * v[j][3]); }
        const float rs = rsqrtf(wave_sum(s) * (1.f / 1024.f) + EPS);
        f32x4* op = (f32x4*)(A.out + ((size_t)(r >> 11) * SEQ + sl * SL + (r & (SL - 1))) * DM) + lane;
#pragma unroll
        for (int j = 0; j < 4; ++j) op[64 * j] = v[j] * rs * gr[64 * j];
    }
}

#ifndef MK_PER_PHASE
#define MK_PER_PHASE 0
#endif
constexpr int PH_PER_SLICE = 12, N_PHASES = 1 + NSLICE * PH_PER_SLICE;

__global__ void __launch_bounds__(NWAVES * 64, 2) mk_fwd(Args args) {
    extern __shared__ __attribute__((aligned(16))) unsigned char lds_[];
    Ctx C;
    C.lds = (LAS unsigned char*)lds_;
    C.tid = threadIdx.x; C.lane = C.tid & 63; C.wave = __builtin_amdgcn_readfirstlane(C.tid >> 6);
    C.G = gridDim.x; { const int bx = blockIdx.x; C.vcu = (C.G % 8 == 0) ? (bx % 8) * (C.G / 8) + bx / 8 : bx; }
    C.out = args.out; C.ws = args.ws;
    unsigned char* ws = args.ws;
    volatile LAS unsigned* MISC = (volatile LAS unsigned*)(C.lds + MISC_OFF);
    if (C.tid < 64) MISC[C.tid] = 0u;
    __syncthreads();
    unsigned* barw = (unsigned*)(ws + WS_CTL) + CW_BAR;
    XcdBarrier bar; bar.bar = barw; bar.x = 0; bar.st = nullptr;
    const int lo = args.ph_lo, hi = args.ph_hi;
    if (hi - lo > 1) bar = xcd_barrier_post(barw, MISC + 8);
#define SEAM(id) do { if ((id) + 1 < hi) xcd_barrier(bar); } while (0)
#ifndef ONLY
#define ONLY -1
#endif
#define KIND(k) (ONLY < 0 || ONLY == (k))
#define IN(id) (lo <= (id) && (id) < hi)

    if (KIND(0) && IN(0)) { phase_prep(C, args); SEAM(0); }
    for (int sl = 0; sl < NSLICE; ++sl) {
        const int base = 1 + sl * PH_PER_SLICE;
        ws = opq_p(ws);
        if (KIND(1) && IN(base + 0)) {
            const int Mrows = (sl == 0) ? RP : RS;
            pg8::Gemm g{(const bf16*)(ws + WS_U0), (const bf16*)(ws + WS_WIN), Mrows, NPROJ, DM}; pg8::StaticOrder S; S.init(Mrows, NPROJ, C.G, (int)blockIdx.x);
            pg8::EpiProj E{(bf16*)(ws + WS_Z), (bf16*)(ws + WS_XS), (bf16*)(ws + WS_BM), (bf16*)(ws + WS_CM), (bf16*)(ws + WS_SB), (bf16*)(ws + WS_SC), (bf16*)(ws + WS_SX), (bf16*)(ws + WS_GT), (float*)(ws + WS_DT)};
            pg8::gemm_phase<pg8::EpiProj, pg8::StaticOrder, true, true>(C.lds, g, S, E);
            SEAM(base + 0);
        }
        if (KIND(2) && IN(base + 1)) { phase_scan(C, args, sl); SEAM(base + 1); }
        if (KIND(3) && IN(base + 2)) { phase_elem(C, args, sl); SEAM(base + 2); }
        if (KIND(4) && IN(base + 3)) {
            pg8::Gemm g{(const bf16*)(ws + WS_XS), (const bf16*)(ws + WS_WSSD), RS, DM, 2048}; pg8::StaticOrder S; S.init(RS, DM, C.G, (int)blockIdx.x);
            pg8::EpiF32Plain E{(float*)(ws + WS_BM), DM};
            pg8::gemm_phase<pg8::EpiF32Plain, pg8::StaticOrder, true, true>(C.lds, g, S, E);
            SEAM(base + 3);
        }
        if (KIND(5) && IN(base + 4)) {
            pg8::Gemm g{(const bf16*)(ws + WS_U0), (const bf16*)(ws + WS_WSC), RS, DM, DM}; pg8::StaticOrder S; S.init(RS, DM, C.G, (int)blockIdx.x);
            pg8::EpiMerge E{(const float*)(ws + WS_BM), (const bf16*)(ws + WS_GT), (bf16*)(ws + WS_SX)};
            pg8::gemm_phase<pg8::EpiMerge, pg8::StaticOrder, true, true>(C.lds, g, S, E);
            SEAM(base + 4);
        }
        if (KIND(6) && IN(base + 5)) {
            pg8::Gemm g{(const bf16*)(ws + WS_SX), (const bf16*)(ws + WS_WO), RS, DM, DM}; pg8::StaticOrder S; S.init(RS, DM, C.G, (int)blockIdx.x);
            pg8::EpiWo E{args.in[I_X], (float*)(ws + WS_Z), sl * SL};
            pg8::gemm_phase<pg8::EpiWo, pg8::StaticOrder, true, true>(C.lds, g, S, E);
            SEAM(base + 5);
        }
        if (KIND(7) && IN(base + 6)) { phase_norm(C, args, sl); SEAM(base + 6); }
        if (KIND(8) && IN(base + 7)) {
            pg8::Gemm g{(const bf16*)(ws + WS_BM), (const bf16*)(ws + WS_WQ), RS, 2048, DM}; pg8::StaticOrder S; S.init(RS, 2048, C.G, (int)blockIdx.x);
            pg8::EpiBf16Plain E{(bf16*)(ws + WS_GT), 2048};
            pg8::gemm_phase<pg8::EpiBf16Plain, pg8::StaticOrder, true, true>(C.lds, g, S, E);
            SEAM(base + 7);
        }
        if (KIND(9) && IN(base + 8)) { phase_topk(C); SEAM(base + 8); }
        if (KIND(10) && IN(base + 9)) { phase_peer_dots(C); SEAM(base + 9); }
        if (KIND(11) && IN(base + 10)) { phase_peer_out(C); SEAM(base + 10); }
        if (KIND(12) && IN(base + 11)) { phase_final(C, args, sl); SEAM(base + 11); }
    }
#undef SEAM
#undef IN
}

extern "C" void kernel_launch(void* const* d_in, const int* in_sizes, int n_in, void* d_out, int out_size, void* d_ws, size_t ws_size, hipStream_t stream) {
    static int ready = 0;
    if (ready == 0) {
        if (n_in != 20 || ws_size < WS_END) { fprintf(stderr, "kernel_launch: unexpected inputs (n_in %d, ws %zu)\n", n_in, ws_size); ready = -1; return; }
        if (hipFuncSetAttribute((const void*)mk_fwd, hipFuncAttributeMaxDynamicSharedMemorySize, LDS_BYTES) != hipSuccess) { fprintf(stderr, "kernel_launch: hipFuncSetAttribute failed\n"); ready = -1; return; }
        ready = 1;
    }
    if (ready < 0) return;
    (void)hipMemsetAsync((char*)d_ws + WS_CTL, 0, CTL_ZERO_BYTES, stream);
    Args a{};
    for (int i = 0; i < 20; ++i) a.in[i] = (const float*)d_in[i];
    a.out = (float*)d_out; a.ws = (unsigned char*)d_ws;
    const int grid = 256;
#if MK_PER_PHASE
    for (int p = 0; p < N_PHASES; ++p) { a.ph_lo = p; a.ph_hi = p + 1; hipLaunchKernelGGL(mk_fwd, dim3(grid), dim3(NWAVES * 64), LDS_BYTES, stream, a); }
#else
    a.ph_lo = 0; a.ph_hi = N_PHASES;
    hipLaunchKernelGGL(mk_fwd, dim3(grid), dim3(NWAVES * 64), LDS_BYTES, stream, a);
#endif
}
```

```cpp
#include <hip/hip_runtime.h>
#include <cstdio>
#include <cstdint>
#include <cmath>
namespace pg8 {
#define PG8_LAS __attribute__((address_space(3)))
typedef unsigned short bf16_t;
typedef short bf16x8 __attribute__((ext_vector_type(8)));
typedef float f32x4 __attribute__((ext_vector_type(4)));
typedef unsigned u32x4 __attribute__((ext_vector_type(4)));
constexpr int BM = 256, BK = 64, HALF = 128, HTB = HALF * BK * 2  , STAGE_BYTES = 8 * HTB, NXCD = 8, WGM = 8;

__host__ __device__ __forceinline__ int lds_byte(int r, int c) { const int st = (r >> 4) * 2 + (c >> 5), rr = r & 15, cc = c & 31, ob = rr * 64 + cc * 2; return st * 1024 + (ob ^ (((ob >> 9) & 1) << 5)); }
__host__ __device__ __forceinline__ void stage_rc(int b, int& R, int& C) { const int st = b / 1024, sb = b % 1024, swz = sb ^ (((sb >> 9) & 1) << 5); R = (st >> 1) * 16 + swz / 64; C = (st & 1) * 32 + (swz % 64) / 2; }
__host__ __device__ __forceinline__ int perm32(int rho) { const int n = rho >> 4, i = rho & 15; return 8 * (i >> 2) + 4 * n + (i & 3); }

struct Unit { int pm, pn; };
struct Gemm { const bf16_t* A; const bf16_t* Bt; int M, N, K; };

struct StaticOrder {
    int nM, nN, nwg, G, c;
    __host__ __device__ void init(int M, int N, int G_, int c_) { nM = M / BM; nN = N / BM; nwg = nM * nN; G = G_; c = c_; }
    __host__ __device__ bool next(int i, Unit& u) const {
        const long L = (long)i * G + c; if (L >= nwg) return false;
        int wgid = (int)L; { const int q = nwg / NXCD, r = nwg % NXCD, xcd = wgid % NXCD, off = wgid / NXCD; wgid = (xcd < r ? xcd * (q + 1) : r * (q + 1) + (xcd - r) * q) + off; }
        const int nig = WGM * nN, gid = wgid / nig, fm = gid * WGM, gsz = (nM - fm) < WGM ? (nM - fm) : WGM;
        u.pm = fm + ((wgid % nig) % gsz); u.pn = (wgid % nig) / gsz; return true;
    }
    __device__ __forceinline__ void a_ready(const Unit&) const {}
    __device__ __forceinline__ void done(const Unit&) const {}
};

__device__ __forceinline__ unsigned cvt_pk_bf16(float lo, float hi) { unsigned r; asm volatile("v_cvt_pk_bf16_f32 %0, %1, %2" : "=v"(r) : "v"(lo), "v"(hi)); return r; }
typedef float f32x2 __attribute__((ext_vector_type(2)));
__device__ __forceinline__ float fast_sigmoid(float x) { return __builtin_amdgcn_rcpf(1.0f + __expf(-x)); }
__device__ __forceinline__ float bflo(unsigned u) { return __builtin_bit_cast(float, u << 16); }
__device__ __forceinline__ float bfhi(unsigned u) { return __builtin_bit_cast(float, u & 0xffff0000u); }

struct EpiProj {
    static constexpr bool PERM = true, AFTER_DRAIN = false;
    bf16_t *Zb, *XS, *BMb, *CMb, *SBb, *SCb, *SXb, *GT; float* DT;
    __device__ __forceinline__ void operator()(const f32x4 (&acc)[2][2][4][2], const Unit& u, int wr, int wc, int fr, int fq) const {
        const int row0 = u.pm * BM + wr * 64 + fr; const int pn = u.pn;
        if (pn == 44) {
            if (wc == 0) {
#pragma unroll
                for (int ai = 0; ai < 2; ++ai)
#pragma unroll
                    for (int m = 0; m < 4; ++m) { float* rp = DT + (size_t)(row0 + ai * HALF + m * 16) * 32 + 8 * fq;
                        *(f32x4*)(rp) = acc[ai][0][m][0]; *(f32x4*)(rp + 4) = acc[ai][0][m][1]; }
            }
            return;
        }
        bf16_t* base; int ld, colt;
        if (pn < 8) { base = Zb; ld = 2048; colt = pn * 256; }
        else if (pn < 16) { base = XS; ld = 2048; colt = (pn - 8) * 256; }
        else if (pn < 20) { base = BMb; ld = 1024; colt = (pn - 16) * 256; }
        else if (pn < 24) { base = CMb; ld = 1024; colt = (pn - 20) * 256; }
        else if (pn < 28) { base = SBb; ld = 1024; colt = (pn - 24) * 256; }
        else if (pn < 32) { base = SCb; ld = 1024; colt = (pn - 28) * 256; }
        else if (pn < 36) { base = SXb; ld = 1024; colt = (pn - 32) * 256; }
        else { base = GT; ld = 2048; colt = (pn - 36) * 256; }
        const int col0 = colt + wc * 32 + 8 * fq;
#pragma unroll
        for (int ai = 0; ai < 2; ++ai)
#pragma unroll
            for (int m = 0; m < 4; ++m) { bf16_t* rowp = base + (size_t)(row0 + ai * HALF + m * 16) * ld + col0;
#pragma unroll
                for (int bj = 0; bj < 2; ++bj) { const f32x4 v0 = acc[ai][bj][m][0], v1 = acc[ai][bj][m][1];
                    u32x4 w; w.x = cvt_pk_bf16(v0[0], v0[1]); w.y = cvt_pk_bf16(v0[2], v0[3]); w.z = cvt_pk_bf16(v1[0], v1[1]); w.w = cvt_pk_bf16(v1[2], v1[3]);
                    *(u32x4*)(rowp + bj * HALF) = w; } }
    }
};
struct EpiBf16Plain {
    static constexpr bool PERM = true, AFTER_DRAIN = false;
    bf16_t* O; int ldc;
    __device__ __forceinline__ void operator()(const f32x4 (&acc)[2][2][4][2], const Unit& u, int wr, int wc, int fr, int fq) const {
        const int row0 = u.pm * BM + wr * 64 + fr; const int col0 = u.pn * BM + wc * 32 + 8 * fq;
#pragma unroll
        for (int ai = 0; ai < 2; ++ai)
#pragma unroll
            for (int m = 0; m < 4; ++m) { bf16_t* rowp = O + (size_t)(row0 + ai * HALF + m * 16) * ldc + col0;
#pragma unroll
                for (int bj = 0; bj < 2; ++bj) { const f32x4 v0 = acc[ai][bj][m][0], v1 = acc[ai][bj][m][1];
                    u32x4 w; w.x = cvt_pk_bf16(v0[0], v0[1]); w.y = cvt_pk_bf16(v0[2], v0[3]); w.z = cvt_pk_bf16(v1[0], v1[1]); w.w = cvt_pk_bf16(v1[2], v1[3]);
                    *(u32x4*)(rowp + bj * HALF) = w; } }
    }
};
struct EpiF32Plain {
    static constexpr bool PERM = false, AFTER_DRAIN = false;
    float* C; int ldc;
    __device__ __forceinline__ void operator()(const f32x4 (&acc)[2][2][4][2], const Unit& u, int wr, int wc, int fr, int fq) const {
        const int row0 = u.pm * BM + wr * 64 + fr, col0 = u.pn * BM + wc * 32 + 4 * fq;
#pragma unroll
        for (int ai = 0; ai < 2; ++ai)
#pragma unroll
            for (int m = 0; m < 4; ++m) { float* rowp = C + (size_t)(row0 + ai * HALF + m * 16) * ldc + col0;
#pragma unroll
                for (int bj = 0; bj < 2; ++bj)
#pragma unroll
                    for (int n = 0; n < 2; ++n) *(f32x4*)(rowp + bj * HALF + n * 16) = acc[ai][bj][m][n]; }
    }
};
struct EpiMerge {
    static constexpr bool PERM = false, AFTER_DRAIN = false;
    const float* YS; const bf16_t* GT; bf16_t* O;
    __device__ __forceinline__ void operator()(const f32x4 (&acc)[2][2][4][2], const Unit& u, int wr, int wc, int fr, int fq) const {
        const int row0 = u.pm * BM + wr * 64 + fr, col0 = u.pn * BM + wc * 32 + 4 * fq;
#pragma unroll
        for (int ai = 0; ai < 2; ++ai)
#pragma unroll
            for (int m = 0; m < 4; ++m) { const size_t row = (size_t)(row0 + ai * HALF + m * 16);
#pragma unroll
                for (int bj = 0; bj < 2; ++bj)
#pragma unroll
                    for (int n = 0; n < 2; ++n) { const int col = col0 + bj * HALF + n * 16;
                        const f32x4 ys = *(const f32x4*)(YS + row * 1024 + col);
                        const uint2 g1 = *(const uint2*)(GT + row * 2048 + col), g2 = *(const uint2*)(GT + row * 2048 + 1024 + col);
                        const f32x4 a = acc[ai][bj][m][n];
                        const float o0 = fast_sigmoid(bflo(g1.x)) * ys[0] + fast_sigmoid(bflo(g2.x)) * a[0];
                        const float o1 = fast_sigmoid(bfhi(g1.x)) * ys[1] + fast_sigmoid(bfhi(g2.x)) * a[1];
                        const float o2 = fast_sigmoid(bflo(g1.y)) * ys[2] + fast_sigmoid(bflo(g2.y)) * a[2];
                        const float o3 = fast_sigmoid(bfhi(g1.y)) * ys[3] + fast_sigmoid(bfhi(g2.y)) * a[3];
                        uint2 w; w.x = cvt_pk_bf16(o0, o1); w.y = cvt_pk_bf16(o2, o3);
                        *(uint2*)(O + row * 1024 + col) = w; } }
    }
};
struct EpiWo {
    static constexpr bool PERM = false, AFTER_DRAIN = false;
    const float* X; float* H1; int soff;
    __device__ __forceinline__ void operator()(const f32x4 (&acc)[2][2][4][2], const Unit& u, int wr, int wc, int fr, int fq) const {
        const int row0 = u.pm * BM + wr * 64 + fr, col0 = u.pn * BM + wc * 32 + 4 * fq;
#pragma unroll
        for (int ai = 0; ai < 2; ++ai)
#pragma unroll
            for (int m = 0; m < 4; ++m) { const int r = row0 + ai * HALF + m * 16; const size_t xr = (size_t)((r >> 11) * 4096 + soff + (r & 2047));
                const float* xp = X + xr * 1024 + col0; float* hp = H1 + (size_t)r * 1024 + col0;
#pragma unroll
                for (int bj = 0; bj < 2; ++bj)
#pragma unroll
                    for (int n = 0; n < 2; ++n) *(f32x4*)(hp + bj * HALF + n * 16) = *(const f32x4*)(xp + bj * HALF + n * 16) + acc[ai][bj][m][n]; }
    }
};
template <class Epi, class Sched, bool ALIGN_EPI = false, bool SP2 = false>
__device__ __forceinline__ void gemm_phase(PG8_LAS unsigned char* lds, const Gemm g, const Sched& S, const Epi& E) {
    int tid_ = threadIdx.x; asm volatile("" : "+v"(tid_)); const int tid = tid_, wid = __builtin_amdgcn_readfirstlane(tid >> 6), lane = tid & 63, wr = wid >> 2, wc = wid & 3, fr = lane & 15, fq = lane >> 4;
    const int K = g.K, nt = K / BK;
    unsigned voffA[2], voffB[2];
#pragma unroll
    for (int i = 0; i < 2; ++i) { int R, C; stage_rc(tid * 16 + i * 8192, R, C); const int Rb = Epi::PERM ? ((R & ~31) + perm32(R & 31)) : R;
        voffA[i] = (unsigned)(R * K + C) * 2u; voffB[i] = (unsigned)(Rb * K + C) * 2u; }
    const size_t kstep = (size_t)(BK * 2);
    const size_t hstep = (size_t)HALF * K * 2;
    const size_t tstep = 2 * hstep;
    const unsigned ldsw = (unsigned)wid * 1024u;
    const int aoff = lds_byte(wr * 64 + fr, fq * 8), boff = lds_byte(wc * 32 + fr, fq * 8);
#define PG8_SA(b, h) (((b) * 2 + (h)) * HTB)
#define PG8_SB(b, h) ((4 + (b) * 2 + (h)) * HTB)
#define PG8_STAGE(bufoff, gbase, voff) do { _Pragma("unroll") for (int _i = 0; _i < 2; ++_i) \
        __builtin_amdgcn_global_load_lds((const unsigned*)((const char*)(gbase) + (voff)[_i]), (PG8_LAS unsigned*)(lds + (bufoff) + ldsw + _i * 8192), 16, 0, 0); } while (0)
#define PG8_LDA(dst, b, h) do { _Pragma("unroll") for (int m = 0; m < 4; ++m) _Pragma("unroll") for (int k = 0; k < 2; ++k) dst[m][k] = *(const PG8_LAS bf16x8*)(lds + PG8_SA(b, h) + aoff + m * 2048 + k * 1024); } while (0)
#define PG8_LDB(dst, b, h) do { _Pragma("unroll") for (int n = 0; n < 2; ++n) _Pragma("unroll") for (int k = 0; k < 2; ++k) dst[n][k] = *(const PG8_LAS bf16x8*)(lds + PG8_SB(b, h) + boff + n * 2048 + k * 1024); } while (0)
#define PG8_MMA(ai, bj, At, Bt) do { __builtin_amdgcn_s_setprio(1); _Pragma("unroll") for (int m = 0; m < 4; ++m) _Pragma("unroll") for (int n = 0; n < 2; ++n) _Pragma("unroll") for (int k = 0; k < 2; ++k) \
        acc[ai][bj][m][n] = __builtin_amdgcn_mfma_f32_16x16x32_bf16(Bt[n][k], At[m][k], acc[ai][bj][m][n], 0, 0, 0); __builtin_amdgcn_s_setprio(0); } while (0)
#define PG8_WAIT_V(n) asm volatile("s_waitcnt vmcnt(" #n ")" ::: "memory")
#define PG8_WAIT_L(n) asm volatile("s_waitcnt lgkmcnt(" #n ")" ::: "memory")
#define PG8_BAR __builtin_amdgcn_s_barrier()
#define PG8_SCHED __builtin_amdgcn_sched_barrier(0)
    Unit cur, nxt; int ui = 0;
    if (!S.next(0, cur)) return;
    f32x4 acc[2][2][4][2];
#pragma unroll
    for (int a = 0; a < 2; ++a)
#pragma unroll
        for (int b = 0; b < 2; ++b)
#pragma unroll
            for (int m = 0; m < 4; ++m)
#pragma unroll
                for (int n = 0; n < 2; ++n) acc[a][b][m][n] = (f32x4){0.f, 0.f, 0.f, 0.f};
    bf16x8 At[4][2], B0[2][2], B1[2][2];
    const char* cA = (const char*)g.A + (size_t)cur.pm * tstep; const char* cB = (const char*)g.Bt + (size_t)cur.pn * tstep;
    S.a_ready(cur);
    if constexpr (SP2) {
        PG8_STAGE(PG8_SB(0, 0), cB, voffB); PG8_STAGE(PG8_SB(0, 1), cB + hstep, voffB); PG8_STAGE(PG8_SA(0, 0), cA, voffA); PG8_STAGE(PG8_SA(0, 1), cA + hstep, voffA);
        if (wr == 1) PG8_BAR;
        PG8_WAIT_V(2); PG8_BAR;
        PG8_STAGE(PG8_SB(1, 0), cB + kstep, voffB); PG8_STAGE(PG8_SA(1, 0), cA + kstep, voffA); PG8_STAGE(PG8_SB(1, 1), cB + hstep + kstep, voffB);
        PG8_WAIT_V(6); PG8_BAR;
    } else {
        PG8_STAGE(PG8_SB(0, 0), cB, voffB); PG8_STAGE(PG8_SA(0, 0), cA, voffA); PG8_STAGE(PG8_SB(0, 1), cB + hstep, voffB); PG8_STAGE(PG8_SA(0, 1), cA + hstep, voffA);
        if (wr == 1) PG8_BAR;
        PG8_WAIT_V(4); PG8_BAR;
        PG8_STAGE(PG8_SB(1, 0), cB + kstep, voffB); PG8_STAGE(PG8_SA(1, 0), cA + kstep, voffA); PG8_STAGE(PG8_SB(1, 1), cB + hstep + kstep, voffB);
        PG8_WAIT_V(6); PG8_BAR;
    }
    for (;;) {
        const bool has_next = S.next(ui + 1, nxt);
        const char* nA = has_next ? (const char*)g.A + (size_t)nxt.pm * tstep : cA; const char* nB = has_next ? (const char*)g.Bt + (size_t)nxt.pn * tstep : cB;
        for (int t = 0; t < nt; t += 2) {
            const bool last = (t == nt - 2);
            const char* a1 = cA + (size_t)(t + 1) * kstep;
            const char* a2 = last ? nA : cA + (size_t)(t + 2) * kstep; const char* b2 = last ? nB : cB + (size_t)(t + 2) * kstep;
            const char* a3 = a2 + kstep; const char* b3 = b2 + kstep;
            if (last && has_next) S.a_ready(nxt);
            if constexpr (SP2) {
            PG8_LDB(B0, 0, 0); PG8_LDB(B1, 0, 1); PG8_SCHED; PG8_LDA(At, 0, 0); PG8_STAGE(PG8_SA(1, 1), a1 + hstep, voffA);
            PG8_WAIT_V(8); PG8_WAIT_L(0); PG8_BAR; PG8_MMA(0, 0, At, B0); PG8_MMA(0, 1, At, B1); PG8_BAR; PG8_SCHED;
            PG8_LDA(At, 0, 1); PG8_STAGE(PG8_SB(0, 0), b2, voffB); PG8_STAGE(PG8_SB(0, 1), b2 + hstep, voffB); PG8_STAGE(PG8_SA(0, 0), a2, voffA);
            PG8_WAIT_V(8); PG8_WAIT_L(0); PG8_BAR; PG8_MMA(1, 0, At, B0); PG8_MMA(1, 1, At, B1); PG8_BAR; PG8_SCHED;
            PG8_LDB(B0, 1, 0); PG8_LDB(B1, 1, 1); PG8_SCHED; PG8_LDA(At, 1, 0); PG8_STAGE(PG8_SA(0, 1), a2 + hstep, voffA);
            PG8_WAIT_V(8); PG8_WAIT_L(0); PG8_BAR; PG8_MMA(0, 0, At, B0); PG8_MMA(0, 1, At, B1); PG8_BAR; PG8_SCHED;
            PG8_LDA(At, 1, 1); PG8_STAGE(PG8_SB(1, 0), b3, voffB); PG8_STAGE(PG8_SB(1, 1), b3 + hstep, voffB); PG8_STAGE(PG8_SA(1, 0), a3, voffA);
            PG8_WAIT_V(8); PG8_WAIT_L(0); PG8_BAR; PG8_MMA(1, 0, At, B0); PG8_MMA(1, 1, At, B1); PG8_BAR; PG8_SCHED;
            } else {
            PG8_LDB(B0, 0, 0); PG8_SCHED; PG8_LDA(At, 0, 0); PG8_STAGE(PG8_SA(1, 1), a1 + hstep, voffA);
            PG8_WAIT_L(8); PG8_BAR; PG8_WAIT_L(0); PG8_MMA(0, 0, At, B0); PG8_BAR; PG8_SCHED;
            PG8_LDB(B1, 0, 1); PG8_STAGE(PG8_SB(0, 0), b2, voffB);
            PG8_BAR; PG8_WAIT_L(0); PG8_MMA(0, 1, At, B1); PG8_BAR;
            PG8_LDA(At, 0, 1); PG8_STAGE(PG8_SA(0, 0), a2, voffA);
            PG8_BAR; PG8_WAIT_L(0); PG8_MMA(1, 0, At, B0); PG8_BAR; PG8_SCHED;
            PG8_STAGE(PG8_SB(0, 1), b2 + hstep, voffB);
            PG8_WAIT_V(6); PG8_BAR; PG8_MMA(1, 1, At, B1); PG8_BAR;
            PG8_LDB(B0, 1, 0); PG8_SCHED; PG8_LDA(At, 1, 0); PG8_STAGE(PG8_SA(0, 1), a2 + hstep, voffA);
            PG8_WAIT_L(8); PG8_BAR; PG8_WAIT_L(0); PG8_MMA(0, 0, At, B0); PG8_BAR; PG8_SCHED;
            PG8_LDB(B1, 1, 1); PG8_STAGE(PG8_SB(1, 0), b3, voffB);
            PG8_BAR; PG8_WAIT_L(0); PG8_MMA(0, 1, At, B1); PG8_BAR;
            PG8_LDA(At, 1, 1); PG8_STAGE(PG8_SA(1, 0), a3, voffA);
            PG8_BAR; PG8_WAIT_L(0); PG8_MMA(1, 0, At, B0); PG8_BAR; PG8_SCHED;
            PG8_STAGE(PG8_SB(1, 1), b3 + hstep, voffB);
            PG8_WAIT_V(6); PG8_BAR; PG8_MMA(1, 1, At, B1); PG8_BAR;
            }
        }
        if constexpr (ALIGN_EPI) { if (wr == 0) PG8_BAR; }
        if constexpr (!Epi::AFTER_DRAIN) { E(acc, cur, wr, wc, fr, fq); S.done(cur); }
        if (!has_next) break;
#pragma unroll
        for (int a = 0; a < 2; ++a)
#pragma unroll
            for (int b = 0; b < 2; ++b)
#pragma unroll
                for (int m = 0; m < 4; ++m)
#pragma unroll
                    for (int n = 0; n < 2; ++n) acc[a][b][m][n] = (f32x4){0.f, 0.f, 0.f, 0.f};
        cur = nxt; cA = nA; cB = nB; ++ui;
        if constexpr (ALIGN_EPI) { if (wr == 1) PG8_BAR; }
    }
    PG8_WAIT_V(0);
    if constexpr (!ALIGN_EPI) { if (wr == 0) PG8_BAR; }
    PG8_BAR;
    if constexpr (Epi::AFTER_DRAIN) { E.fused(acc, cur, wr, wc, fr, fq, lds, wid, lane); S.done(cur); }
#undef PG8_SA
#undef PG8_SB
#undef PG8_STAGE
#undef PG8_LDA
#undef PG8_LDB
#undef PG8_MMA
#undef PG8_WAIT_V
#undef PG8_WAIT_L
#undef PG8_BAR
#undef PG8_SCHED
}
}

#define GAS __attribute__((address_space(1)))
#define LAS __attribute__((address_space(3)))
typedef unsigned short bf16;
typedef unsigned v4u __attribute__((ext_vector_type(4)));
typedef unsigned v2u __attribute__((ext_vector_type(2)));
typedef float f32x4 __attribute__((ext_vector_type(4)));
typedef float f32x16 __attribute__((ext_vector_type(16)));
typedef short bf16x8 __attribute__((ext_vector_type(8)));
#define LDS_WAIT() asm volatile("s_waitcnt lgkmcnt(0)" ::: "memory")
#define VM_WAIT() asm volatile("s_waitcnt vmcnt(0)" ::: "memory")

constexpr int NB = 8, SEQ = 4096, DM = 1024, NSLICE = 2, SL = SEQ / NSLICE, RS = NB * SL, RP = RS + 256;
constexpr int NPROJ = 11520;
constexpr float EPS = 1e-6f;
constexpr int NWAVES = 8;
constexpr size_t MiB = 1u << 20;
constexpr size_t WS_CTL = 0, CTL_ZERO_BYTES = 1 * MiB;
constexpr size_t WS_WIN = 1 * MiB;
constexpr size_t WS_WSSD = WS_WIN + 23592960;
constexpr size_t WS_WSC = WS_WSSD + 4 * MiB;
constexpr size_t WS_WO = WS_WSC + 2 * MiB;
constexpr size_t WS_WQ = WS_WO + 2 * MiB;
constexpr size_t WS_SK = WS_WQ + 4 * MiB;
constexpr size_t WS_EU = WS_SK + MiB / 2;
constexpr size_t WS_EV = WS_EU + 16 * MiB;
constexpr size_t WS_SU = WS_EV + 16 * MiB;
constexpr size_t WS_SV = WS_SU + MiB / 4;
constexpr size_t WS_STATE = WS_SV + MiB / 4;
constexpr size_t WS_HALO = WS_STATE + 8 * MiB;
constexpr size_t WS_SCH = WS_HALO + MiB / 2;
constexpr size_t WS_U0 = WS_SCH + MiB / 2;
constexpr size_t SZ_R1 = (size_t)RP * 1024 * 2;
constexpr size_t WS_Z = WS_U0 + SZ_R1;
constexpr size_t WS_XS = WS_Z + 2 * SZ_R1;
constexpr size_t WS_BM = WS_XS + 2 * SZ_R1;
constexpr size_t WS_CM = WS_BM + SZ_R1;
constexpr size_t WS_DT = WS_CM + SZ_R1;
constexpr size_t WS_SB = WS_DT + 5 * MiB / 2;
constexpr size_t WS_SC = WS_SB + SZ_R1;
constexpr size_t WS_SX = WS_SC + SZ_R1;
constexpr size_t WS_GT = WS_SX + SZ_R1;
constexpr size_t WS_END = WS_GT + 2 * SZ_R1;
static_assert(WS_END <= 512 * MiB, "workspace map exceeds 512 MiB");
static_assert((size_t)RP * 32 * 4 <= 5 * MiB / 2, "dt");
constexpr int CW_BAR = 4096;
constexpr int LDS_BYTES = 163840;
constexpr int MISC_OFF = LDS_BYTES - 256;

__device__ __forceinline__ unsigned pk2(float lo, float hi) { unsigned r; asm("v_cvt_pk_bf16_f32 %0, %1, %2" : "=v"(r) : "v"(lo), "v"(hi)); return r; }
__device__ __forceinline__ float bf2f(bf16 v) { return __builtin_bit_cast(float, (unsigned)v << 16); }
__device__ __forceinline__ bf16 f2bf1(float f) { return (bf16)(pk2(f, 0.f) & 0xffffu); }
__device__ __forceinline__ float blo(unsigned u) { return __builtin_bit_cast(float, u << 16); }
__device__ __forceinline__ float bhi(unsigned u) { return __builtin_bit_cast(float, u & 0xffff0000u); }
__device__ __forceinline__ float siluf(float x) { return x * __builtin_amdgcn_rcpf(1.0f + __expf(-x)); }
__device__ __forceinline__ float wave_sum(float v) {
#pragma unroll
    for (int o = 1; o < 64; o <<= 1) v += __shfl_xor(v, o);
    return v;
}
#define XB_TMO      128
#define XB_XCNT(j)  (256  + 64 * (j))
#define XB_XSUB(j)  (1280 + 64 * (j))
#define XB_XGEN(j)  (2304 + 64 * (j))
#define XB_TOP      3328
#define XB_TOPGEN   3392
#define XCD_BAR_WORDS 3456
#define XB_SPIN_CAP (1u << 18)

__device__ __forceinline__ unsigned xb_ld(unsigned* p)              { return __hip_atomic_load(p, __ATOMIC_RELAXED, __HIP_MEMORY_SCOPE_AGENT); }
__device__ __forceinline__ unsigned xb_add(unsigned* p, unsigned v) { return __hip_atomic_fetch_add(p, v, __ATOMIC_RELAXED, __HIP_MEMORY_SCOPE_AGENT); }
__device__ __forceinline__ unsigned xb_xcc_id() { return (unsigned)__builtin_amdgcn_s_getreg((3 << 11) | 20) & 0xFu; }
#define XB_SPIN(cond, bar) do { unsigned _sp = 0; while (cond) { __builtin_amdgcn_s_sleep(1); \
    if ((++_sp & 255u) == 0u) { if (xb_ld(&(bar)[XB_TMO])) break; if (_sp > XB_SPIN_CAP) { atomicAdd(&(bar)[XB_TMO], 1u); break; } } } } while (0)

struct XcdBarrier {
    unsigned* bar; unsigned x;
    volatile LAS unsigned* st;
};

__device__ __forceinline__ XcdBarrier xcd_barrier_post(unsigned* bar, volatile LAS unsigned* st) {
    XcdBarrier b; b.bar = bar; b.x = xb_xcc_id(); b.st = st;
    if (threadIdx.x == 0) (void)xb_add(&bar[XB_XCNT(b.x)], 1u);
    return b;
}
__device__ __forceinline__ void xcd_barrier_complete(unsigned* bar, unsigned x, unsigned& nloc, unsigned& nx) {
    const unsigned G = gridDim.x * gridDim.y * gridDim.z;
    unsigned sum, cnt, mine, sp = 0u;
    for (;;) {
        sum = 0u; cnt = 0u; mine = 0u;
#pragma unroll
        for (unsigned j = 0; j < 16; ++j) { const unsigned c = xb_ld(&bar[XB_XCNT(j)]); sum += c; cnt += (c > 0u) ? 1u : 0u; mine = (j == x) ? c : mine; }
        if (sum == G) break;
        __builtin_amdgcn_s_sleep(1);
        if ((++sp & 255u) == 0u) { if (xb_ld(&bar[XB_TMO])) break; if (sp > XB_SPIN_CAP) { atomicAdd(&bar[XB_TMO], 1u); break; } }
    }
    nloc = mine > 0u ? mine : 1u; nx = cnt > 0u ? cnt : 1u;
}

__device__ __forceinline__ void xcd_barrier(const XcdBarrier& b) {
    asm volatile("s_waitcnt vmcnt(0)" ::: "memory");
    __syncthreads();
    if (threadIdx.x == 0) {
        unsigned* bar = b.bar;
        __builtin_amdgcn_s_waitcnt(0);
        unsigned nloc = b.st[0], nx = b.st[1];
        if (nloc == 0u) { xcd_barrier_complete(bar, b.x, nloc, nx); b.st[0] = nloc; b.st[1] = nx; }
        const unsigned old = xb_add(&bar[XB_XSUB(b.x)], 1u);
        const unsigned gen = old / nloc;
        if (old + 1u == (gen + 1u) * nloc) {
            __builtin_amdgcn_fence(__ATOMIC_RELEASE, "agent");
            asm volatile("s_waitcnt vmcnt(0)" ::: "memory");
            const unsigned og = xb_add(&bar[XB_TOP], 1u);
            const unsigned tg = og / nx;
            if (og + 1u == (tg + 1u) * nx) xb_add(&bar[XB_TOPGEN], 1u);
            else XB_SPIN(xb_ld(&bar[XB_TOPGEN]) == tg, bar);
            __builtin_amdgcn_fence(__ATOMIC_ACQUIRE, "agent");
            xb_add(&bar[XB_XGEN(b.x)], 1u);
            asm volatile("s_waitcnt vmcnt(0)" ::: "memory");
        } else {
            XB_SPIN(xb_ld(&bar[XB_XGEN(b.x)]) == gen, bar);
            __builtin_amdgcn_fence(__ATOMIC_ACQUIRE, "agent");
            asm volatile("s_waitcnt vmcnt(0)" ::: "memory");
        }
    }
    __syncthreads();
}


struct Ctx {
    LAS unsigned char* lds;
    int tid, lane, wave, vcu, G;
    float* out;
    unsigned char* ws;
};
struct Args { const float* in[20]; float* out; unsigned char* ws; int ph_lo, ph_hi; };
static_assert(sizeof(Args) == 22 * 8 + 8, "Args has no padding");
__device__ __forceinline__ int opq(int v) { asm volatile("" : "+v"(v)); return v; }
__device__ __forceinline__ unsigned char* opq_p(unsigned char* p) { asm volatile("" : "+s"(p)); return p; }
enum { I_X = 0, I_META, I_LNMIX, I_WIN, I_CONVW, I_CONVB, I_DTB, I_ALOG, I_D, I_NORM, I_WSSD, I_SCCW, I_WSC, I_WO, I_LNFFN, I_WQ, I_SK, I_PU, I_PV, I_LNF };

__device__ __forceinline__ void tr_item(const float* W, int ldw, int src0, int k0, bf16* WT, int K, int n0, LAS float* scr, int lane) {
#pragma unroll 8
    for (int i = 0; i < 32; ++i) { const int kk = 2 * i + (lane >> 5); scr[kk * 33 + (lane & 31)] = (src0 >= 0) ? W[(size_t)(k0 + kk) * ldw + src0 + (lane & 31)] : 0.f; }
    LDS_WAIT(); asm volatile("" ::: "memory");
    const int c = lane & 7;
#pragma unroll
    for (int j = 0; j < 4; ++j) { const int n = (lane >> 3) + 8 * j; const LAS float* s = scr + (8 * c) * 33 + n;
        v4u o; o.x = pk2(s[0 * 33], s[1 * 33]); o.y = pk2(s[2 * 33], s[3 * 33]); o.z = pk2(s[4 * 33], s[5 * 33]); o.w = pk2(s[6 * 33], s[7 * 33]);
        *(v4u*)(WT + (size_t)(n0 + n) * K + k0 + 8 * c) = o; }
    LDS_WAIT(); asm volatile("" ::: "memory");
}
__device__ __forceinline__ void cvt_item(const float* src, bf16* dst, int lane) {
#pragma unroll
    for (int i = 0; i < 8; ++i) { const f32x4 a = *(const f32x4*)(src + i * 512 + lane * 8), b = *(const f32x4*)(src + i * 512 + lane * 8 + 4);
        v4u o; o.x = pk2(a[0], a[1]); o.y = pk2(a[2], a[3]); o.z = pk2(b[0], b[1]); o.w = pk2(b[2], b[3]);
        *(v4u*)(dst + i * 512 + lane * 8) = o; }
}
template <bool SLICED> __device__ __forceinline__ void fp8_row(const float* src, unsigned char* dst, float* scale, int e, int lane) {
    f32x4 v[4]; float am = 0.f;
#pragma unroll
    for (int j = 0; j < 4; ++j) { v[j] = *(const f32x4*)(src + (size_t)e * 1024 + 4 * lane + 256 * j); am = fmaxf(am, fmaxf(fmaxf(fabsf(v[j][0]), fabsf(v[j][1])), fmaxf(fabsf(v[j][2]), fabsf(v[j][3])))); }
#pragma unroll
    for (int o = 1; o < 64; o <<= 1) am = fmaxf(am, __shfl_xor(am, o));
    const float s = (am > 0.f) ? am * (1.0f / 440.0f) : 1.0f, inv = 1.0f / s;
    if (lane == 0) scale[e] = s;
#pragma unroll
    for (int j = 0; j < 4; ++j) { int p = __builtin_amdgcn_cvt_pk_fp8_f32(v[j][0] * inv, v[j][1] * inv, 0, false); p = __builtin_amdgcn_cvt_pk_fp8_f32(v[j][2] * inv, v[j][3] * inv, p, true);
        const int c = 4 * lane + 256 * j;
        if (SLICED) *(int*)(dst + ((size_t)(c >> 7) * 16384 + e) * 128 + (c & 127)) = p;
        else *(int*)(dst + (size_t)e * 1024 + c) = p; }
}
__device__ __forceinline__ void rms_row_bf16(const float* xrow, const float* g, bf16* orow, int lane) {
    uint2* o8 = (uint2*)orow + lane;
    if (xrow == nullptr) {
#pragma unroll
        for (int j = 0; j < 4; ++j) o8[64 * j] = make_uint2(0u, 0u);
        return;
    }
    const f32x4* xr = (const f32x4*)xrow + lane; const f32x4* gr = (const f32x4*)g + lane;
    f32x4 v[4]; float s = 0.f;
#pragma unroll
    for (int j = 0; j < 4; ++j) { v[j] = xr[64 * j]; s += (v[j][0] * v[j][0] + v[j][1] * v[j][1]) + (v[j][2] * v[j][2] + v[j][3] * v[j][3]); }
    const float r = rsqrtf(wave_sum(s) * (1.f / 1024.f) + EPS);
#pragma unroll
    for (int j = 0; j < 4; ++j) { const f32x4 gg = gr[64 * j]; o8[64 * j] = make_uint2(pk2(v[j][0] * r * gg[0], v[j][1] * r * gg[1]), pk2(v[j][2] * r * gg[2], v[j][3] * r * gg[3])); }
}
__device__ __forceinline__ const float* u0_src(const Args& A, int sl, int r) {
    if (r < RS) return A.in[I_X] + ((size_t)(r >> 11) * SEQ + sl * SL + (r & (SL - 1))) * DM;
    const int l = r - RS;
    if (l >= 48 && l < 64) return A.in[I_META] + (size_t)(l - 48) * DM;
    return nullptr;
}
__device__ __forceinline__ void phase_prep(Ctx& C, const Args& A) {
    LAS float* scr = (LAS float*)(C.lds + C.wave * 16384);
    const int lane = opq(C.tid) & 63;
    const int gw = C.vcu * NWAVES + C.wave, NGW = C.G * NWAVES;
    unsigned char* ws = opq_p(C.ws);
    constexpr int N_WIN = 16 * 360, N_SSD = 32 * 32, N_SC = 16 * 32, N_WO = 16 * 32, N_WQ = 16 * 64, N_SKC = 64, N_EC = 16384, N_U0 = RP;
    constexpr int NITEMS = N_WIN + N_SSD + N_SC + N_WO + N_WQ + N_SKC + 2 * N_EC + N_U0;
    for (int it = gw; it < NITEMS; it += NGW) {
        int r = it;
        if (r < N_WIN) { const int kb = r / 360, nb = r % 360, n0 = nb * 32;
            const int src0 = (n0 < 6144) ? n0 : (n0 < 11264 ? n0 + 32 : (n0 < 11296 ? n0 - 11264 + 6144 : -1));
            tr_item(A.in[I_WIN], 11296, src0, kb * 64, (bf16*)(ws + WS_WIN), 1024, n0, scr, lane); continue; } r -= N_WIN;
        if (r < N_SSD) { const int kb = r / 32, nb = r % 32; tr_item(A.in[I_WSSD], 1024, nb * 32, kb * 64, (bf16*)(ws + WS_WSSD), 2048, nb * 32, scr, lane); continue; } r -= N_SSD;
        if (r < N_SC) { const int kb = r / 32, nb = r % 32; tr_item(A.in[I_WSC], 1024, nb * 32, kb * 64, (bf16*)(ws + WS_WSC), 1024, nb * 32, scr, lane); continue; } r -= N_SC;
        if (r < N_WO) { const int kb = r / 32, nb = r % 32; tr_item(A.in[I_WO], 1024, nb * 32, kb * 64, (bf16*)(ws + WS_WO), 1024, nb * 32, scr, lane); continue; } r -= N_WO;
        if (r < N_WQ) { const int kb = r / 64, nb = r % 64; tr_item(A.in[I_WQ], 2048, nb * 32, kb * 64, (bf16*)(ws + WS_WQ), 1024, nb * 32, scr, lane); continue; } r -= N_WQ;
        if (r < N_SKC) { cvt_item(A.in[I_SK] + (size_t)r * 4096, (bf16*)(ws + WS_SK) + (size_t)r * 4096, lane); continue; } r -= N_SKC;
        if (r < N_EC) { fp8_row<true>(A.in[I_PU], ws + WS_EU, (float*)(ws + WS_SU), r, lane); continue; } r -= N_EC;
        if (r < N_EC) { fp8_row<true>(A.in[I_PV], ws + WS_EV, (float*)(ws + WS_SV), r, lane); continue; } r -= N_EC;
        rms_row_bf16(u0_src(A, 0, r), A.in[I_LNMIX], (bf16*)(ws + WS_U0) + (size_t)r * DM, lane);
    }
}

constexpr int SC_RAWS = 328;
constexpr int SC_RAW = 0, SC_M = 44032, SC_CC = 53248, SC_BC = 70656, SC_BCT = 88064, SC_XST = 106496, SC_XDTT = 115712, SC_XDTET = 124928, SC_STB = 134144, SC_ACUM = 151552, SC_DTV = 152064;
constexpr int SC_S64 = 72, SC_S128 = 136;
static_assert(SC_DTV + 512 <= MISC_OFF, "scan LDS map");

__device__ __forceinline__ void phase_scan(Ctx& C, const Args& A, int sl) {
    const int tid = opq(C.tid), lane = tid & 63, wave = C.wave, fr = lane & 15, fq = lane >> 4;
    const int bh = C.vcu, b = bh >> 5, h = bh & 31, g = h >> 2;
    unsigned char* ws = opq_p(C.ws);
    bf16* XS = (bf16*)(ws + WS_XS); const bf16* BMp = (const bf16*)(ws + WS_BM); const bf16* CMp = (const bf16*)(ws + WS_CM); const float* DTp = (const float*)(ws + WS_DT);
    LAS bf16* RAW = (LAS bf16*)(C.lds + SC_RAW); LAS bf16* Mm = (LAS bf16*)(C.lds + SC_M); LAS bf16* CC = (LAS bf16*)(C.lds + SC_CC); LAS bf16* BC = (LAS bf16*)(C.lds + SC_BC);
    LAS bf16* BCT = (LAS bf16*)(C.lds + SC_BCT); LAS bf16* XST = (LAS bf16*)(C.lds + SC_XST); LAS bf16* XDTT = (LAS bf16*)(C.lds + SC_XDTT); LAS bf16* XDTET = (LAS bf16*)(C.lds + SC_XDTET);
    LAS bf16* STB = (LAS bf16*)(C.lds + SC_STB); LAS float* ACUM = (LAS float*)(C.lds + SC_ACUM); LAS float* DTV = (LAS float*)(C.lds + SC_DTV);
    const int chx = tid & 63, rbx = tid >> 6, chb = tid & 127, rbb = tid >> 7;
    const float* cw = A.in[I_CONVW]; const float* cb_ = A.in[I_CONVB];
    float wx[4], wB[4], wC[4];
    { const f32x4 t = *(const f32x4*)(cw + (size_t)(h * 64 + chx) * 4); wx[0] = t[0]; wx[1] = t[1]; wx[2] = t[2]; wx[3] = t[3]; }
    { const f32x4 t = *(const f32x4*)(cw + (size_t)(2048 + g * 128 + chb) * 4); wB[0] = t[0]; wB[1] = t[1]; wB[2] = t[2]; wB[3] = t[3]; }
    { const f32x4 t = *(const f32x4*)(cw + (size_t)(3072 + g * 128 + chb) * 4); wC[0] = t[0]; wC[1] = t[1]; wC[2] = t[2]; wC[3] = t[3]; }
    const float bx = cb_[h * 64 + chx], bB = cb_[2048 + g * 128 + chb], bC = cb_[3072 + g * 128 + chb];
    const float dtb = A.in[I_DTB][h], aneg = -__expf(A.in[I_ALOG][h]), dsk = A.in[I_D][h];
    const int tr = wave & 3, tc0 = (wave >> 2) * 2;
    const int tp = wave & 3, tn0 = (wave >> 2) * 4;
    f32x4 st[4];
    float* STATE = (float*)(ws + WS_STATE) + (size_t)bh * 64 * 128;
    bf16* HALO = (bf16*)(ws + WS_HALO) + (size_t)bh * 3 * 320;
    if (sl == 0) {
#pragma unroll
        for (int j = 0; j < 4; ++j) st[j] = (f32x4){0.f, 0.f, 0.f, 0.f};
        for (int i = tid; i < 3 * SC_RAWS; i += 512) RAW[i] = 0;
    } else {
#pragma unroll
        for (int j = 0; j < 4; ++j)
#pragma unroll
            for (int i = 0; i < 4; ++i) st[j][i] = STATE[(tp * 16 + fq * 4 + i) * 128 + (tn0 + j) * 16 + fr];
        for (int i = tid; i < 3 * 320; i += 512) RAW[(i / 320) * SC_RAWS + (i % 320)] = HALO[i];
    }
#pragma unroll
    for (int j = 0; j < 4; ++j)
#pragma unroll
        for (int i = 0; i < 4; ++i) STB[(tp * 16 + fq * 4 + i) * SC_S128 + (tn0 + j) * 16 + fr] = f2bf1(st[j][i]);
    const int c_begin = (sl == 0) ? -1 : 0;
    v4u pre[5]; float dtn = 0.f;
#define ROW_BASE(ci) ((ci) < 0 ? RS : b * SL + (ci) * 64)
#define SCAN_LOAD(ci) do { const int rb_ = ROW_BASE(ci); \
        _Pragma("unroll") for (int i_ = 0; i_ < 5; ++i_) { const int p_ = tid + 512 * i_, r_ = p_ / 40, pc_ = p_ % 40; const size_t gr_ = (size_t)(rb_ + r_); \
            const bf16* src_ = (pc_ < 8) ? (XS + gr_ * 2048 + h * 64 + pc_ * 8) : (pc_ < 24) ? (BMp + gr_ * 1024 + g * 128 + (pc_ - 8) * 8) : (CMp + gr_ * 1024 + g * 128 + (pc_ - 24) * 8); \
            pre[i_] = *(const v4u*)src_; } \
        if (wave == 0) dtn = DTp[(size_t)(rb_ + lane) * 32 + h]; } while (0)
#define SCAN_STORE_RAW() do { _Pragma("unroll") for (int i_ = 0; i_ < 5; ++i_) { const int p_ = tid + 512 * i_, r_ = p_ / 40, pc_ = p_ % 40; \
            *(LAS v4u*)(RAW + (3 + r_) * SC_RAWS + pc_ * 8) = pre[i_]; } } while (0)
#define SCAN_DT(par) do { if (wave == 0) { const float x_ = dtn + dtb; const float dv_ = (x_ > 20.f) ? x_ : log1pf(__expf(x_)); float a_ = aneg * dv_; \
            _Pragma("unroll") for (int o_ = 1; o_ < 64; o_ <<= 1) { const float t_ = __shfl_up(a_, o_); if (lane >= o_) a_ += t_; } \
            ACUM[(par) * 64 + lane] = a_; DTV[(par) * 64 + lane] = dv_; } } while (0)
    SCAN_LOAD(c_begin);
    SCAN_STORE_RAW();
    SCAN_DT(0);
    __syncthreads();
    int par = 0;
    for (int ci = c_begin; ci < SL / 64; ++ci, par ^= 1) {
        const bool has_next = (ci + 1 < SL / 64);
        const int lmask = (ci < 0) ? 48 : 0;
        const LAS float* AC = ACUM + par * 64; const LAS float* DV = DTV + par * 64;
        const float aend = AC[63];
        {
            float r[11];
#pragma unroll
            for (int i = 0; i < 11; ++i) r[i] = bf2f(RAW[(rbx * 8 + i) * SC_RAWS + chx]);
            float xv[8], xd[8], xe[8];
#pragma unroll
            for (int j = 0; j < 8; ++j) { const int l = rbx * 8 + j; float a = bx + wx[0] * r[j] + wx[1] * r[j + 1] + wx[2] * r[j + 2] + wx[3] * r[j + 3];
                a = (l >= lmask) ? siluf(a) : 0.f; xv[j] = a; xd[j] = a * DV[l]; xe[j] = xd[j] * __expf(aend - AC[l]); }
            v4u o;
            o.x = pk2(xv[0], xv[1]); o.y = pk2(xv[2], xv[3]); o.z = pk2(xv[4], xv[5]); o.w = pk2(xv[6], xv[7]); *(LAS v4u*)(XST + chx * SC_S64 + rbx * 8) = o;
            o.x = pk2(xd[0], xd[1]); o.y = pk2(xd[2], xd[3]); o.z = pk2(xd[4], xd[5]); o.w = pk2(xd[6], xd[7]); *(LAS v4u*)(XDTT + chx * SC_S64 + rbx * 8) = o;
            o.x = pk2(xe[0], xe[1]); o.y = pk2(xe[2], xe[3]); o.z = pk2(xe[4], xe[5]); o.w = pk2(xe[6], xe[7]); *(LAS v4u*)(XDTET + chx * SC_S64 + rbx * 8) = o;
        }
        __builtin_amdgcn_sched_barrier(0);
        {
            float r[19];
#pragma unroll
            for (int i = 0; i < 19; ++i) r[i] = bf2f(RAW[(rbb * 16 + i) * SC_RAWS + 64 + chb]);
            float v[16];
#pragma unroll
            for (int j = 0; j < 16; ++j) { const int l = rbb * 16 + j; float a = bB + wB[0] * r[j] + wB[1] * r[j + 1] + wB[2] * r[j + 2] + wB[3] * r[j + 3];
                a = (l >= lmask) ? siluf(a) : 0.f; v[j] = a; BC[l * SC_S128 + chb] = f2bf1(a); }
            v4u o;
            o.x = pk2(v[0], v[1]); o.y = pk2(v[2], v[3]); o.z = pk2(v[4], v[5]); o.w = pk2(v[6], v[7]); *(LAS v4u*)(BCT + chb * SC_S64 + rbb * 16) = o;
            o.x = pk2(v[8], v[9]); o.y = pk2(v[10], v[11]); o.z = pk2(v[12], v[13]); o.w = pk2(v[14], v[15]); *(LAS v4u*)(BCT + chb * SC_S64 + rbb * 16 + 8) = o;
        }
        __builtin_amdgcn_sched_barrier(0);
        {
            float r[19];
#pragma unroll
            for (int i = 0; i < 19; ++i) r[i] = bf2f(RAW[(rbb * 16 + i) * SC_RAWS + 192 + chb]);
#pragma unroll
            for (int j = 0; j < 16; ++j) { const int l = rbb * 16 + j; float a = bC + wC[0] * r[j] + wC[1] * r[j + 1] + wC[2] * r[j + 2] + wC[3] * r[j + 3];
                a = (l >= lmask) ? siluf(a) : 0.f; CC[l * SC_S128 + chb] = f2bf1(a); }
        }
        __syncthreads();
        if (has_next) SCAN_LOAD(ci + 1);
        if (tid < 123) { const v4u t = *(LAS v4u*)((LAS unsigned char*)RAW + 64 * SC_RAWS * 2 + tid * 16); *(LAS v4u*)((LAS unsigned char*)RAW + tid * 16) = t; }
        bf16x8 ca[4];
#pragma unroll
        for (int kk = 0; kk < 4; ++kk) ca[kk] = *(LAS bf16x8*)(CC + (tr * 16 + fr) * SC_S128 + kk * 32 + fq * 8);
        f32x4 yacc[2];
#pragma unroll
        for (int t = 0; t < 2; ++t) {
            const int tc = tc0 + t;
            f32x4 a1 = {0.f, 0.f, 0.f, 0.f}, a2 = {0.f, 0.f, 0.f, 0.f};
#pragma unroll
            for (int kk = 0; kk < 4; ++kk) {
                const bf16x8 bb = *(LAS bf16x8*)(BC + (tc * 16 + fr) * SC_S128 + kk * 32 + fq * 8);
                const bf16x8 sb = *(LAS bf16x8*)(STB + (tc * 16 + fr) * SC_S128 + kk * 32 + fq * 8);
                a1 = __builtin_amdgcn_mfma_f32_16x16x32_bf16(ca[kk], bb, a1, 0, 0, 0);
                a2 = __builtin_amdgcn_mfma_f32_16x16x32_bf16(ca[kk], sb, a2, 0, 0, 0);
            }
            const int s = tc * 16 + fr; const float as = AC[s];
#pragma unroll
            for (int i = 0; i < 4; ++i) { const int l = tr * 16 + fq * 4 + i; const float al = AC[l];
                const float mv = (l >= s) ? a1[i] * __expf(al - as) : 0.f;
                Mm[l * SC_S64 + s] = f2bf1(mv);
                yacc[t][i] = a2[i] * __expf(al); }
        }
        {
            const float dec = __expf(aend);
            bf16x8 xa[2];
#pragma unroll
            for (int kk = 0; kk < 2; ++kk) xa[kk] = *(LAS bf16x8*)(XDTET + (tp * 16 + fr) * SC_S64 + kk * 32 + fq * 8);
#pragma unroll
            for (int j = 0; j < 4; ++j) { st[j] = st[j] * dec;
#pragma unroll
                for (int kk = 0; kk < 2; ++kk) { const bf16x8 bb = *(LAS bf16x8*)(BCT + ((tn0 + j) * 16 + fr) * SC_S64 + kk * 32 + fq * 8);
                    st[j] = __builtin_amdgcn_mfma_f32_16x16x32_bf16(xa[kk], bb, st[j], 0, 0, 0); } }
        }
        __syncthreads();
#pragma unroll
        for (int j = 0; j < 4; ++j)
#pragma unroll
            for (int i = 0; i < 4; ++i) STB[(tp * 16 + fq * 4 + i) * SC_S128 + (tn0 + j) * 16 + fr] = f2bf1(st[j][i]);
        {
            bf16x8 ma[2];
#pragma unroll
            for (int kk = 0; kk < 2; ++kk) ma[kk] = *(LAS bf16x8*)(Mm + (tr * 16 + fr) * SC_S64 + kk * 32 + fq * 8);
            const int rb0 = ROW_BASE(ci);
#pragma unroll
            for (int t = 0; t < 2; ++t) { const int p = (tc0 + t) * 16 + fr;
#pragma unroll
                for (int kk = 0; kk < 2; ++kk) { const bf16x8 xb = *(LAS bf16x8*)(XDTT + p * SC_S64 + kk * 32 + fq * 8);
                    yacc[t] = __builtin_amdgcn_mfma_f32_16x16x32_bf16(ma[kk], xb, yacc[t], 0, 0, 0); }
                if (ci >= 0) {
#pragma unroll
                    for (int i = 0; i < 4; ++i) { const int l = tr * 16 + fq * 4 + i; const float yv = yacc[t][i] + dsk * bf2f(XST[p * SC_S64 + l]);
                        XS[(size_t)(rb0 + l) * 2048 + h * 64 + p] = f2bf1(yv); }
                }
            }
        }
        if (has_next) { SCAN_STORE_RAW(); SCAN_DT(par ^ 1); }
        __syncthreads();
    }
    if (sl + 1 < NSLICE) {
#pragma unroll
        for (int j = 0; j < 4; ++j)
#pragma unroll
            for (int i = 0; i < 4; ++i) STATE[(tp * 16 + fq * 4 + i) * 128 + (tn0 + j) * 16 + fr] = st[j][i];
        for (int i = tid; i < 3 * 320; i += 512) HALO[i] = RAW[(i / 320) * SC_RAWS + (i % 320)];
    }
#undef SCAN_LOAD
#undef ROW_BASE
#undef SCAN_STORE_RAW
#undef SCAN_DT
}

__device__ __forceinline__ void phase_elem(Ctx& C, const Args& A, int sl) {
    const int gw = C.vcu * NWAVES + C.wave, lane = opq(C.tid) & 63;
    unsigned char* ws = opq_p(C.ws);
    bf16* XS = (bf16*)(ws + WS_XS); const bf16* Zb = (const bf16*)(ws + WS_Z);
    {
        const float* ng = A.in[I_NORM];
        f32x4 gq[4][2];
#pragma unroll
        for (int j = 0; j < 4; ++j) { gq[j][0] = *(const f32x4*)(ng + 8 * lane + 512 * j); gq[j][1] = *(const f32x4*)(ng + 8 * lane + 512 * j + 4); }
        for (int rr = 0; rr < 8; ++rr) {
            const size_t r = (size_t)gw * 8 + rr;
            v4u yv[4], zv[4];
#pragma unroll
            for (int j = 0; j < 4; ++j) { yv[j] = *(const v4u*)(XS + r * 2048 + 8 * lane + 512 * j); zv[j] = *(const v4u*)(Zb + r * 2048 + 8 * lane + 512 * j); }
#pragma unroll
            for (int j = 0; j < 4; ++j) {
                float v[8];
#pragma unroll
                for (int q = 0; q < 4; ++q) { v[2 * q] = blo(yv[j][q]) * siluf(blo(zv[j][q])); v[2 * q + 1] = bhi(yv[j][q]) * siluf(bhi(zv[j][q])); }
                float ss = 0.f;
#pragma unroll
                for (int q = 0; q < 8; ++q) ss += v[q] * v[q];
#pragma unroll
                for (int o = 1; o < 32; o <<= 1) ss += __shfl_xor(ss, o);
                const float rs = rsqrtf(ss * (1.f / 256.f) + EPS);
                v4u o4; o4.x = pk2(v[0] * rs * gq[j][0][0], v[1] * rs * gq[j][0][1]); o4.y = pk2(v[2] * rs * gq[j][0][2], v[3] * rs * gq[j][0][3]);
                o4.z = pk2(v[4] * rs * gq[j][1][0], v[5] * rs * gq[j][1][1]); o4.w = pk2(v[6] * rs * gq[j][1][2], v[7] * rs * gq[j][1][3]);
                *(v4u*)(XS + r * 2048 + 8 * lane + 512 * j) = o4;
            }
        }
    }
    {
        const bf16* SBp = (const bf16*)(ws + WS_SB); const bf16* SCp = (const bf16*)(ws + WS_SC); const bf16* SXp = (const bf16*)(ws + WS_SX);
        bf16* SCV = (bf16*)(ws + WS_U0); float* SCH = (float*)(ws + WS_SCH);
        const float* w3 = A.in[I_SCCW];
        const int r0 = gw * 8, b = r0 >> 11, s0 = r0 & (SL - 1);
#pragma unroll
        for (int j = 0; j < 2; ++j) {
            const int ch0 = 8 * lane + 512 * j;
            float w0[8], w1[8], w2[8];
#pragma unroll
            for (int q = 0; q < 8; ++q) { w0[q] = w3[(ch0 + q) * 3 + 0]; w1[q] = w3[(ch0 + q) * 3 + 1]; w2[q] = w3[(ch0 + q) * 3 + 2]; }
            float pm2[8], pm1[8];
            if (s0 == 0 && sl > 0) {
#pragma unroll
                for (int q = 0; q < 8; ++q) { pm2[q] = SCH[(b * 2 + 0) * 1024 + ch0 + q]; pm1[q] = SCH[(b * 2 + 1) * 1024 + ch0 + q]; }
            } else {
                const size_t ra = (s0 == 0) ? (size_t)(RS + 62) : (size_t)(r0 - 2), rb = (s0 == 0) ? (size_t)(RS + 63) : (size_t)(r0 - 1);
                const v4u c2 = *(const v4u*)(SCp + ra * 1024 + ch0), x2 = *(const v4u*)(SXp + ra * 1024 + ch0), c1 = *(const v4u*)(SCp + rb * 1024 + ch0), x1 = *(const v4u*)(SXp + rb * 1024 + ch0);
#pragma unroll
                for (int q = 0; q < 4; ++q) { pm2[2 * q] = blo(c2[q]) * blo(x2[q]); pm2[2 * q + 1] = bhi(c2[q]) * bhi(x2[q]); pm1[2 * q] = blo(c1[q]) * blo(x1[q]); pm1[2 * q + 1] = bhi(c1[q]) * bhi(x1[q]); }
            }
            for (int rr = 0; rr < 8; ++rr) {
                const size_t r = (size_t)r0 + rr;
                const v4u cv = *(const v4u*)(SCp + r * 1024 + ch0), xv = *(const v4u*)(SXp + r * 1024 + ch0), bv = *(const v4u*)(SBp + r * 1024 + ch0);
                float p0[8], o[8];
#pragma unroll
                for (int q = 0; q < 4; ++q) { p0[2 * q] = blo(cv[q]) * blo(xv[q]); p0[2 * q + 1] = bhi(cv[q]) * bhi(xv[q]); }
#pragma unroll
                for (int q = 0; q < 4; ++q) { o[2 * q] = blo(bv[q]) * (w0[2 * q] * pm2[2 * q] + w1[2 * q] * pm1[2 * q] + w2[2 * q] * p0[2 * q]);
                    o[2 * q + 1] = bhi(bv[q]) * (w0[2 * q + 1] * pm2[2 * q + 1] + w1[2 * q + 1] * pm1[2 * q + 1] + w2[2 * q + 1] * p0[2 * q + 1]); }
                v4u o4; o4.x = pk2(o[0], o[1]); o4.y = pk2(o[2], o[3]); o4.z = pk2(o[4], o[5]); o4.w = pk2(o[6], o[7]);
                *(v4u*)(SCV + r * 1024 + ch0) = o4;
#pragma unroll
                for (int q = 0; q < 8; ++q) { pm2[q] = pm1[q]; pm1[q] = p0[q]; }
            }
            if (sl + 1 < NSLICE && s0 == SL - 8) {
#pragma unroll
                for (int q = 0; q < 8; ++q) { SCH[(b * 2 + 0) * 1024 + ch0 + q] = pm2[q]; SCH[(b * 2 + 1) * 1024 + ch0 + q] = pm1[q]; }
            }
        }
    }
}

__device__ __forceinline__ void phase_norm(Ctx& C, const Args& A, int sl) {
    const int gw = C.vcu * NWAVES + C.wave, NGW = C.G * NWAVES, lane = opq(C.tid) & 63;
    unsigned char* ws = opq_p(C.ws);
    const float* H1 = (const float*)(ws + WS_Z); bf16* U1 = (bf16*)(ws + WS_BM);
    for (int r = gw; r < RS; r += NGW) rms_row_bf16(H1 + (size_t)r * DM, A.in[I_LNFFN], U1 + (size_t)r * DM, lane);
    if (sl + 1 < NSLICE) for (int r = gw; r < RS; r += NGW) rms_row_bf16(u0_src(A, sl + 1, r), A.in[I_LNMIX], (bf16*)(ws + WS_U0) + (size_t)r * DM, lane);
}

__device__ __forceinline__ int med3i(int a, int b, int c) { int r; asm("v_med3_i32 %0, %1, %2, %3" : "=v"(r) : "v"(a), "v"(b), "v"(c)); return r; }
__device__ __forceinline__ int ord_key(float f) { int k = __builtin_bit_cast(int, f); return k ^ ((k >> 31) & 0x7fffffff); }
__device__ __forceinline__ float ord_val(int k) { return __builtin_bit_cast(float, k ^ ((k >> 31) & 0x7fffffff)); }
#define TK_INSERT(L, x) do { const int x_ = (x); \
    L[15] = med3i(L[14], x_, L[15]); L[14] = med3i(L[13], x_, L[14]); L[13] = med3i(L[12], x_, L[13]); L[12] = med3i(L[11], x_, L[12]); \
    L[11] = med3i(L[10], x_, L[11]); L[10] = med3i(L[9], x_, L[10]); L[9] = med3i(L[8], x_, L[9]); L[8] = med3i(L[7], x_, L[8]); \
    L[7] = med3i(L[6], x_, L[7]); L[6] = med3i(L[5], x_, L[6]); L[5] = med3i(L[4], x_, L[5]); L[4] = med3i(L[3], x_, L[4]); \
    L[3] = med3i(L[2], x_, L[3]); L[2] = med3i(L[1], x_, L[2]); L[1] = med3i(L[0], x_, L[1]); L[0] = max(L[0], x_); } while (0)
constexpr int TK_QS = 264;

__device__ __forceinline__ void phase_topk(Ctx& C) {
    const int lane = opq(C.tid) & 63;
    const int gw = C.vcu * NWAVES + C.wave, NGW = C.G * NWAVES, r32 = lane & 31, hf = lane >> 5;
    unsigned char* ws = opq_p(C.ws);
    const bf16* Q = (const bf16*)(ws + WS_GT); const bf16* SK = (const bf16*)(ws + WS_SK);
    int* EIDX = (int*)(ws + WS_SB); float* GWV = (float*)(ws + WS_SB + 8 * MiB); float* SUW = (float*)(ws + WS_SB + 16 * MiB);
    const float* SU = (const float*)(ws + WS_SU); const float* SV = (const float*)(ws + WS_SV);
    LAS bf16* Qs = (LAS bf16*)(C.lds + C.wave * 17408);
    for (int task = gw; task < (RS / 32) * 8; task += NGW) {
        const int tb = task >> 3, hh = task & 7, r0 = tb * 32;
#pragma unroll
        for (int i = 0; i < 16; ++i) { const int piece = i * 64 + lane, row = piece >> 5, c16 = piece & 31;
            *(LAS v4u*)(Qs + row * TK_QS + c16 * 8) = *(const v4u*)(Q + (size_t)(r0 + row) * 2048 + hh * 256 + c16 * 8); }
        LDS_WAIT(); asm volatile("" ::: "memory");
        int LA[16], LB[16];
#pragma unroll
        for (int j = 0; j < 2; ++j) {
            f32x16 acc[4];
#pragma unroll
            for (int kb = 0; kb < 4; ++kb)
#pragma unroll
                for (int q = 0; q < 16; ++q) acc[kb][q] = 0.f;
            const bf16* skp = SK + (size_t)((hh * 2 + j) * 128 + r32) * 128 + hf * 8;
#pragma unroll 2
            for (int kk = 0; kk < 8; ++kk) {
                const bf16x8 bq = *(LAS bf16x8*)(Qs + r32 * TK_QS + j * 128 + kk * 16 + hf * 8);
#pragma unroll
                for (int kb = 0; kb < 4; ++kb) { const bf16x8 ak = *(const bf16x8*)(skp + (size_t)kb * 32 * 128 + kk * 16);
                    acc[kb] = __builtin_amdgcn_mfma_f32_32x32x16_bf16(ak, bq, acc[kb], 0, 0, 0); }
            }
            int L[16];
#pragma unroll
            for (int q = 0; q < 16; ++q) L[q] = (int)0x80000000;
#pragma unroll
            for (int kb = 0; kb < 4; ++kb)
#pragma unroll
                for (int q = 0; q < 16; ++q) { const int key = kb * 32 + (q & 3) + 8 * (q >> 2) + 4 * hf;
                    const int x = (ord_key(acc[kb][q]) & ~127) | (127 - key); TK_INSERT(L, x); }
            int T[16];
#pragma unroll
            for (int q = 0; q < 16; ++q) T[q] = __shfl_xor(L[q], 32);
#pragma unroll
            for (int q = 0; q < 16; ++q) TK_INSERT(L, T[q]);
            if (j == 0) {
#pragma unroll
                for (int q = 0; q < 16; ++q) LA[q] = L[q];
            } else {
#pragma unroll
                for (int q = 0; q < 16; ++q) LB[q] = L[q];
            }
        }
        float av[16], bv[16]; unsigned pa[4] = {0u, 0u, 0u, 0u}, pb[4] = {0u, 0u, 0u, 0u};
#pragma unroll
        for (int q = 0; q < 16; ++q) { av[q] = ord_val(LA[q] & ~127); bv[q] = ord_val(LB[q] & ~127);
            pa[q >> 2] |= (unsigned)(127 - (LA[q] & 127)) << (8 * (q & 3)); pb[q >> 2] |= (unsigned)(127 - (LB[q] & 127)) << (8 * (q & 3)); }
        int LC[16];
#pragma unroll
        for (int q = 0; q < 16; ++q) LC[q] = (int)0x80000000;
#pragma unroll
        for (int i = 0; i < 16; ++i)
#pragma unroll
            for (int jj = 0; jj < 16; ++jj)
                if ((i + 1) * (jj + 1) <= 16) { const int x = (ord_key(av[i] + bv[jj]) & ~255) | (255 - (i * 16 + jj)); TK_INSERT(LC, x); }
        float cs[16], es[16], esum = 0.f; int ei[16];
#pragma unroll
        for (int q = 0; q < 16; ++q) { cs[q] = ord_val(LC[q] & ~255); const int ci = 255 - (LC[q] & 255), i = ci >> 4, jj = ci & 15;
            const unsigned wa = (i < 8) ? ((i < 4) ? pa[0] : pa[1]) : ((i < 12) ? pa[2] : pa[3]);
            const unsigned wb = (jj < 8) ? ((jj < 4) ? pb[0] : pb[1]) : ((jj < 12) ? pb[2] : pb[3]);
            const int i1 = (wa >> (8 * (i & 3))) & 255, i2 = (wb >> (8 * (jj & 3))) & 255;
            ei[q] = i1 * 128 + i2; }
#pragma unroll
        for (int q = 0; q < 16; ++q) { es[q] = __expf(cs[q] - cs[0]); esum += es[q]; }
        const float rinv = 1.0f / esum;
        if (hf == 0) {
            int* ep = EIDX + (size_t)(r0 + r32) * 128 + hh * 16; float* gp = GWV + (size_t)(r0 + r32) * 128 + hh * 16; float* sp = SUW + (size_t)(r0 + r32) * 128 + hh * 16;
            float su_[16], sv_[16];
#pragma unroll
            for (int q = 0; q < 16; ++q) { su_[q] = SU[ei[q]]; sv_[q] = SV[ei[q]]; }
#pragma unroll
            for (int q = 0; q < 4; ++q) { *(int4*)(ep + 4 * q) = make_int4(ei[4 * q], ei[4 * q + 1], ei[4 * q + 2], ei[4 * q + 3]);
                *(f32x4*)(gp + 4 * q) = (f32x4){es[4 * q] * rinv * sv_[4 * q], es[4 * q + 1] * rinv * sv_[4 * q + 1], es[4 * q + 2] * rinv * sv_[4 * q + 2], es[4 * q + 3] * rinv * sv_[4 * q + 3]};
                *(f32x4*)(sp + 4 * q) = (f32x4){su_[4 * q], su_[4 * q + 1], su_[4 * q + 2], su_[4 * q + 3]}; }
        }
        LDS_WAIT(); asm volatile("" ::: "memory");
    }
}

typedef float f32x2v __attribute__((ext_vector_type(2)));
__device__ __forceinline__ void fp8x16_to_f32(const v4u r, float (&f)[16]) {
#pragma unroll
    for (int q = 0; q < 4; ++q) { const f32x2v lo = __builtin_amdgcn_cvt_pk_f32_fp8((int)r[q], false), hi = __builtin_amdgcn_cvt_pk_f32_fp8((int)r[q], true);
        f[4 * q] = lo[0]; f[4 * q + 1] = lo[1]; f[4 * q + 2] = hi[0]; f[4 * q + 3] = hi[1]; }
}
__device__ __forceinline__ float gelu_erf(float x) { return 0.5f * x * (1.0f + erff(x * 0.70710678118654752f)); }

struct PeerStage { v4u rows[16]; float aux[16]; int t; };
__device__ __forceinline__ void lds_slots16(LAS int* El, int rg, int (&ee)[16]) {
    typedef int v4i_ __attribute__((ext_vector_type(4)));
#pragma unroll
    for (int q = 0; q < 4; ++q) { const v4i_ ev = *(LAS v4i_*)(El + rg * 16 + 4 * q); ee[4 * q] = ev[0]; ee[4 * q + 1] = ev[1]; ee[4 * q + 2] = ev[2]; ee[4 * q + 3] = ev[3]; }
}
struct DotsMeta { int e0, e1; v4u ua, ub; };
__device__ __forceinline__ void phase_peer_dots(Ctx& C) {
    const int lane = opq(C.tid) & 63, rg = lane >> 3, ck = lane & 7;
    const int x = C.vcu >> 5, wv = (C.vcu & 31) * NWAVES + C.wave;
    unsigned char* ws = opq_p(C.ws);
    const bf16* U1 = (const bf16*)(ws + WS_BM) + 128 * x + ck * 16; const int* EIDX = (const int*)(ws + WS_SB);
    float* PART = (float*)(ws + WS_XS) + (size_t)x * RS * 128;
    const unsigned char* EU8 = ws + WS_EU + (size_t)x * 16384 * 128 + ck * 16;
    LAS int* El = (LAS int*)(C.lds + C.wave * 1024);
#define DM_LOAD(M, tt) do { const int t_ = (tt) < RS ? (tt) : RS - 1; M.e0 = EIDX[(size_t)t_ * 128 + lane]; M.e1 = EIDX[(size_t)t_ * 128 + 64 + lane]; \
        M.ua = *(const v4u*)(U1 + (size_t)t_ * DM); M.ub = *(const v4u*)(U1 + (size_t)t_ * DM + 8); } while (0)
#define DM_STAGE(S, M, tt) do { S.t = (tt); El[lane] = M.e0; El[64 + lane] = M.e1; LDS_WAIT(); asm volatile("" ::: "memory"); int ee_[16]; lds_slots16(El, rg, ee_); \
        _Pragma("unroll") for (int i_ = 0; i_ < 16; ++i_) S.rows[i_] = *(const v4u*)(EU8 + (size_t)ee_[i_] * 128); \
        _Pragma("unroll") for (int q_ = 0; q_ < 4; ++q_) { S.aux[2 * q_] = blo(M.ua[q_]); S.aux[2 * q_ + 1] = bhi(M.ua[q_]); S.aux[8 + 2 * q_] = blo(M.ub[q_]); S.aux[8 + 2 * q_ + 1] = bhi(M.ub[q_]); } \
        LDS_WAIT(); asm volatile("" ::: "memory"); } while (0)
#define DM_COMPUTE(S) do { float p_[16]; \
        _Pragma("unroll") for (int i_ = 0; i_ < 16; ++i_) { float f_[16]; fp8x16_to_f32(S.rows[i_], f_); float s0_ = 0.f, s1_ = 0.f; \
            _Pragma("unroll") for (int q_ = 0; q_ < 8; ++q_) { s0_ = fmaf(f_[2 * q_], S.aux[2 * q_], s0_); s1_ = fmaf(f_[2 * q_ + 1], S.aux[2 * q_ + 1], s1_); } p_[i_] = s0_ + s1_; } \
        float q8_[8], q4_[4], q2_[2]; \
        { const bool bt_ = lane & 1; _Pragma("unroll") for (int m_ = 0; m_ < 8; ++m_) { const float k_ = bt_ ? p_[2 * m_ + 1] : p_[2 * m_], s_ = bt_ ? p_[2 * m_] : p_[2 * m_ + 1]; q8_[m_] = k_ + __shfl_xor(s_, 1); } } \
        { const bool bt_ = lane & 2; _Pragma("unroll") for (int m_ = 0; m_ < 4; ++m_) { const float k_ = bt_ ? q8_[2 * m_ + 1] : q8_[2 * m_], s_ = bt_ ? q8_[2 * m_] : q8_[2 * m_ + 1]; q4_[m_] = k_ + __shfl_xor(s_, 2); } } \
        { const bool bt_ = lane & 4; _Pragma("unroll") for (int m_ = 0; m_ < 2; ++m_) { const float k_ = bt_ ? q4_[2 * m_ + 1] : q4_[2 * m_], s_ = bt_ ? q4_[2 * m_] : q4_[2 * m_ + 1]; q2_[m_] = k_ + __shfl_xor(s_, 4); } } \
        float* pp_ = PART + (size_t)S.t * 128 + rg * 16 + ck; pp_[0] = q2_[0]; pp_[8] = q2_[1]; } while (0)
    DotsMeta m0, m1; PeerStage sA, sB;
    DM_LOAD(m0, wv); DM_STAGE(sA, m0, wv); DM_LOAD(m1, wv + 256);
    for (int t = wv; t < RS; t += 512) {
        DM_STAGE(sB, m1, t + 256); DM_LOAD(m0, t + 512);
        DM_COMPUTE(sA);
        DM_STAGE(sA, m0, (t + 512 < RS) ? t + 512 : RS - 1); DM_LOAD(m1, t + 768);
        DM_COMPUTE(sB);
    }
#undef DM_LOAD
#undef DM_STAGE
#undef DM_COMPUTE
}
__device__ __forceinline__ void phase_peer_w(Ctx& C) {
    const int gw = C.vcu * NWAVES + C.wave, NGW = C.G * NWAVES, lane = opq(C.tid) & 63;
    unsigned char* ws = opq_p(C.ws);
    const float* PART = (const float*)(ws + WS_XS); const float* GWV = (const float*)(ws + WS_SB + 8 * MiB); const float* SUW = (const float*)(ws + WS_SB + 16 * MiB); float* W = (float*)(ws + WS_SB + 24 * MiB);
    for (int r = gw; r < RS / 2; r += NGW) {
        const size_t o = (size_t)(2 * r) * 128 + 4 * lane;
        f32x4 s = *(const f32x4*)(PART + o);
#pragma unroll
        for (int xx = 1; xx < 8; ++xx) s += *(const f32x4*)(PART + (size_t)xx * RS * 128 + o);
        const f32x4 su = *(const f32x4*)(SUW + o), gv = *(const f32x4*)(GWV + o);
        f32x4 w;
#pragma unroll
        for (int q = 0; q < 4; ++q) w[q] = gv[q] * gelu_erf(s[q] * su[q]);
        *(f32x4*)(W + o) = w;
    }
}
struct OutMeta { int e0, e1; float w0, w1; };
__device__ __forceinline__ void phase_peer_out(Ctx& C) {
    const int lane = opq(C.tid) & 63, rg = lane >> 3, ck = lane & 7;
    const int x = C.vcu >> 5, wv = (C.vcu & 31) * NWAVES + C.wave;
    unsigned char* ws = opq_p(C.ws);
    const int* EIDX = (const int*)(ws + WS_SB); const float* W = (const float*)(ws + WS_SB + 24 * MiB);
    float* FF = (float*)(ws + WS_XS) + 128 * x + ck * 16 + rg;
    const unsigned char* EV8 = ws + WS_EV + (size_t)x * 16384 * 128 + ck * 16;
    LAS int* El = (LAS int*)(C.lds + C.wave * 1024); LAS float* Wl = (LAS float*)(C.lds + C.wave * 1024 + 512);
#define OM_LOAD(M, tt) do { const int t_ = (tt) < RS ? (tt) : RS - 1; M.e0 = EIDX[(size_t)t_ * 128 + lane]; M.e1 = EIDX[(size_t)t_ * 128 + 64 + lane]; \
        M.w0 = W[(size_t)t_ * 128 + lane]; M.w1 = W[(size_t)t_ * 128 + 64 + lane]; } while (0)
#define OM_STAGE(S, M, tt) do { S.t = (tt); El[lane] = M.e0; El[64 + lane] = M.e1; Wl[lane] = M.w0; Wl[64 + lane] = M.w1; LDS_WAIT(); asm volatile("" ::: "memory"); int ee_[16]; lds_slots16(El, rg, ee_); \
        _Pragma("unroll") for (int i_ = 0; i_ < 16; ++i_) S.rows[i_] = *(const v4u*)(EV8 + (size_t)ee_[i_] * 128); \
        _Pragma("unroll") for (int q_ = 0; q_ < 4; ++q_) { const f32x4 w4_ = *(LAS f32x4*)(Wl + rg * 16 + 4 * q_); S.aux[4 * q_] = w4_[0]; S.aux[4 * q_ + 1] = w4_[1]; S.aux[4 * q_ + 2] = w4_[2]; S.aux[4 * q_ + 3] = w4_[3]; } \
        LDS_WAIT(); asm volatile("" ::: "memory"); } while (0)
#define OM_COMPUTE(S) do { float acc_[16]; \
        _Pragma("unroll") for (int q_ = 0; q_ < 16; ++q_) acc_[q_] = 0.f; \
        _Pragma("unroll") for (int i_ = 0; i_ < 16; ++i_) { float f_[16]; fp8x16_to_f32(S.rows[i_], f_); \
            _Pragma("unroll") for (int q_ = 0; q_ < 16; ++q_) acc_[q_] = fmaf(S.aux[i_], f_[q_], acc_[q_]); } \
        float q8_[8], q4_[4], q2_[2]; \
        { const bool bt_ = lane & 8; _Pragma("unroll") for (int m_ = 0; m_ < 8; ++m_) { const float k_ = bt_ ? acc_[2 * m_ + 1] : acc_[2 * m_], s_ = bt_ ? acc_[2 * m_] : acc_[2 * m_ + 1]; q8_[m_] = k_ + __shfl_xor(s_, 8); } } \
        { const bool bt_ = lane & 16; _Pragma("unroll") for (int m_ = 0; m_ < 4; ++m_) { const float k_ = bt_ ? q8_[2 * m_ + 1] : q8_[2 * m_], s_ = bt_ ? q8_[2 * m_] : q8_[2 * m_ + 1]; q4_[m_] = k_ + __shfl_xor(s_, 16); } } \
        { const bool bt_ = lane & 32; _Pragma("unroll") for (int m_ = 0; m_ < 2; ++m_) { const float k_ = bt_ ? q4_[2 * m_ + 1] : q4_[2 * m_], s_ = bt_ ? q4_[2 * m_] : q4_[2 * m_ + 1]; q2_[m_] = k_ + __shfl_xor(s_, 32); } } \
        float* fp_ = FF + (size_t)S.t * DM; fp_[0] = q2_[0]; fp_[8] = q2_[1]; } while (0)
    OutMeta m0, m1; PeerStage sA, sB;
    OM_LOAD(m0, wv); OM_STAGE(sA, m0, wv); OM_LOAD(m1, wv + 256);
    for (int t = wv; t < RS; t += 512) {
        OM_STAGE(sB, m1, t + 256); OM_LOAD(m0, t + 512);
        OM_COMPUTE(sA);
        OM_STAGE(sA, m0, (t + 512 < RS) ? t + 512 : RS - 1); OM_LOAD(m1, t + 768);
        OM_COMPUTE(sB);
    }
#undef OM_LOAD
#undef OM_STAGE
#undef OM_COMPUTE
}

__device__ __forceinline__ void phase_final(Ctx& C, const Args& A, int sl) {
    const int gw = C.vcu * NWAVES + C.wave, NGW = C.G * NWAVES, lane = opq(C.tid) & 63;
    unsigned char* ws = opq_p(C.ws);
    const float* H1 = (const float*)(ws + WS_Z); const float* FF = (const float*)(ws + WS_XS);
    const f32x4* gr = (const f32x4*)A.in[I_LNF] + lane;
    for (int r = gw; r < RS; r += NGW) {
        const f32x4* hp = (const f32x4*)(H1 + (size_t)r * DM) + lane; const f32x4* fp = (const f32x4*)(FF + (size_t)r * DM) + lane;
        f32x4 v[4]; float s = 0.f;
#pragma unroll
        for (int j = 0; j < 4; ++j) { v[j] = hp[64 * j] + fp[64 * j]; s += (v[j][0] * v[j][0] + v[j][1] * v[j][1]) + (v[j][2] * v[j][2] + v[j][3] * v[j][3]); }
        const float rs = rsqrtf(wave_sum(s) * (1.f / 1024.f) + EPS);
        f32x4* op = (f32x4*)(A.out + ((size_t)(r >> 11) * SEQ + sl * SL + (r & (SL - 1))) * DM) + lane;
#pragma unroll
        for (int j = 0; j < 4; ++j) op[64 * j] = v[j] * rs * gr[64 * j];
    }
}

#ifndef MK_PER_PHASE
#define MK_PER_PHASE 0
#endif
constexpr int PH_PER_SLICE = 13, N_PHASES = 1 + NSLICE * PH_PER_SLICE;

__global__ void __launch_bounds__(NWAVES * 64, 2) mk_fwd(Args args) {
    extern __shared__ __attribute__((aligned(16))) unsigned char lds_[];
    Ctx C;
    C.lds = (LAS unsigned char*)lds_;
    C.tid = threadIdx.x; C.lane = C.tid & 63; C.wave = __builtin_amdgcn_readfirstlane(C.tid >> 6);
    C.G = gridDim.x; { const int bx = blockIdx.x; C.vcu = (C.G % 8 == 0) ? (bx % 8) * (C.G / 8) + bx / 8 : bx; }
    C.out = args.out; C.ws = args.ws;
    unsigned char* ws = args.ws;
    volatile LAS unsigned* MISC = (volatile LAS unsigned*)(C.lds + MISC_OFF);
    if (C.tid < 64) MISC[C.tid] = 0u;
    __syncthreads();
    unsigned* barw = (unsigned*)(ws + WS_CTL) + CW_BAR;
    XcdBarrier bar; bar.bar = barw; bar.x = 0; bar.st = nullptr;
    const int lo = args.ph_lo, hi = args.ph_hi;
    if (hi - lo > 1) bar = xcd_barrier_post(barw, MISC + 8);
#define SEAM(id) do { if ((id) + 1 < hi) xcd_barrier(bar); } while (0)
#ifndef ONLY
#define ONLY -1
#endif
#define KIND(k) (ONLY < 0 || ONLY == (k))
#define IN(id) (lo <= (id) && (id) < hi)

    if (KIND(0) && IN(0)) { phase_prep(C, args); SEAM(0); }
    for (int sl = 0; sl < NSLICE; ++sl) {
        const int base = 1 + sl * PH_PER_SLICE;
        ws = opq_p(ws);
        if (KIND(1) && IN(base + 0)) {
            const int Mrows = (sl == 0) ? RP : RS;
            pg8::Gemm g{(const bf16*)(ws + WS_U0), (const bf16*)(ws + WS_WIN), Mrows, NPROJ, DM}; pg8::StaticOrder S; S.init(Mrows, NPROJ, C.G, (int)blockIdx.x);
            pg8::EpiProj E{(bf16*)(ws + WS_Z), (bf16*)(ws + WS_XS), (bf16*)(ws + WS_BM), (bf16*)(ws + WS_CM), (bf16*)(ws + WS_SB), (bf16*)(ws + WS_SC), (bf16*)(ws + WS_SX), (bf16*)(ws + WS_GT), (float*)(ws + WS_DT)};
            pg8::gemm_phase<pg8::EpiProj, pg8::StaticOrder, true, true>(C.lds, g, S, E);
            SEAM(base + 0);
        }
        if (KIND(2) && IN(base + 1)) { phase_scan(C, args, sl); SEAM(base + 1); }
        if (KIND(3) && IN(base + 2)) { phase_elem(C, args, sl); SEAM(base + 2); }
        if (KIND(4) && IN(base + 3)) {
            pg8::Gemm g{(const bf16*)(ws + WS_XS), (const bf16*)(ws + WS_WSSD), RS, DM, 2048}; pg8::StaticOrder S; S.init(RS, DM, C.G, (int)blockIdx.x);
            pg8::EpiF32Plain E{(float*)(ws + WS_BM), DM};
            pg8::gemm_phase<pg8::EpiF32Plain, pg8::StaticOrder, true, true>(C.lds, g, S, E);
            SEAM(base + 3);
        }
        if (KIND(5) && IN(base + 4)) {
            pg8::Gemm g{(const bf16*)(ws + WS_U0), (const bf16*)(ws + WS_WSC), RS, DM, DM}; pg8::StaticOrder S; S.init(RS, DM, C.G, (int)blockIdx.x);
            pg8::EpiMerge E{(const float*)(ws + WS_BM), (const bf16*)(ws + WS_GT), (bf16*)(ws + WS_SX)};
            pg8::gemm_phase<pg8::EpiMerge, pg8::StaticOrder, true, true>(C.lds, g, S, E);
            SEAM(base + 4);
        }
        if (KIND(6) && IN(base + 5)) {
            pg8::Gemm g{(const bf16*)(ws + WS_SX), (const bf16*)(ws + WS_WO), RS, DM, DM}; pg8::StaticOrder S; S.init(RS, DM, C.G, (int)blockIdx.x);
            pg8::EpiWo E{args.in[I_X], (float*)(ws + WS_Z), sl * SL};
            pg8::gemm_phase<pg8::EpiWo, pg8::StaticOrder, true, true>(C.lds, g, S, E);
            SEAM(base + 5);
        }
        if (KIND(7) && IN(base + 6)) { phase_norm(C, args, sl); SEAM(base + 6); }
        if (KIND(8) && IN(base + 7)) {
            pg8::Gemm g{(const bf16*)(ws + WS_BM), (const bf16*)(ws + WS_WQ), RS, 2048, DM}; pg8::StaticOrder S; S.init(RS, 2048, C.G, (int)blockIdx.x);
            pg8::EpiBf16Plain E{(bf16*)(ws + WS_GT), 2048};
            pg8::gemm_phase<pg8::EpiBf16Plain, pg8::StaticOrder, true, true>(C.lds, g, S, E);
            SEAM(base + 7);
        }
        if (KIND(9) && IN(base + 8)) { phase_topk(C); SEAM(base + 8); }
        if (KIND(10) && IN(base + 9)) { phase_peer_dots(C); SEAM(base + 9); }
        if (KIND(13) && IN(base + 10)) { phase_peer_w(C); SEAM(base + 10); }
        if (KIND(11) && IN(base + 11)) { phase_peer_out(C); SEAM(base + 11); }
        if (KIND(12) && IN(base + 12)) { phase_final(C, args, sl); SEAM(base + 12); }
    }
#undef SEAM
#undef IN
}

extern "C" void kernel_launch(void* const* d_in, const int* in_sizes, int n_in, void* d_out, int out_size, void* d_ws, size_t ws_size, hipStream_t stream) {
    static int ready = 0;
    if (ready == 0) {
        if (n_in != 20 || ws_size < WS_END) { fprintf(stderr, "kernel_launch: unexpected inputs (n_in %d, ws %zu)\n", n_in, ws_size); ready = -1; return; }
        if (hipFuncSetAttribute((const void*)mk_fwd, hipFuncAttributeMaxDynamicSharedMemorySize, LDS_BYTES) != hipSuccess) { fprintf(stderr, "kernel_launch: hipFuncSetAttribute failed\n"); ready = -1; return; }
        ready = 1;
    }
    if (ready < 0) return;
    (void)hipMemsetAsync((char*)d_ws + WS_CTL, 0, CTL_ZERO_BYTES, stream);
    Args a{};
    for (int i = 0; i < 20; ++i) a.in[i] = (const float*)d_in[i];
    a.out = (float*)d_out; a.ws = (unsigned char*)d_ws;
    const int grid = 256;
#if MK_PER_PHASE
    for (int p = 0; p < N_PHASES; ++p) { a.ph_lo = p; a.ph_hi = p + 1; hipLaunchKernelGGL(mk_fwd, dim3(grid), dim3(NWAVES * 64), LDS_BYTES, stream, a); }
#else
    a.ph_lo = 0; a.ph_hi = N_PHASES;
    hipLaunchKernelGGL(mk_fwd, dim3(grid), dim3(NWAVES * 64), LDS_BYTES, stream, a);
#endif
}
```

```cpp
#include <hip/hip_runtime.h>
#include <cstdio>
#include <cstdint>
#include <cmath>
namespace pg8 {
#define PG8_LAS __attribute__((address_space(3)))
typedef unsigned short bf16_t;
typedef short bf16x8 __attribute__((ext_vector_type(8)));
typedef float f32x4 __attribute__((ext_vector_type(4)));
typedef unsigned u32x4 __attribute__((ext_vector_type(4)));
constexpr int BM = 256, BK = 64, HALF = 128, HTB = HALF * BK * 2  , STAGE_BYTES = 8 * HTB, NXCD = 8, WGM = 8;

__host__ __device__ __forceinline__ int lds_byte(int r, int c) { const int st = (r >> 4) * 2 + (c >> 5), rr = r & 15, cc = c & 31, ob = rr * 64 + cc * 2; return st * 1024 + (ob ^ (((ob >> 9) & 1) << 5)); }
__host__ __device__ __forceinline__ void stage_rc(int b, int& R, int& C) { const int st = b / 1024, sb = b % 1024, swz = sb ^ (((sb >> 9) & 1) << 5); R = (st >> 1) * 16 + swz / 64; C = (st & 1) * 32 + (swz % 64) / 2; }
__host__ __device__ __forceinline__ int perm32(int rho) { const int n = rho >> 4, i = rho & 15; return 8 * (i >> 2) + 4 * n + (i & 3); }

struct Unit { int pm, pn; };
struct Gemm { const bf16_t* A; const bf16_t* Bt; int M, N, K; };

struct StaticOrder {
    int nM, nN, nwg, G, c;
    __host__ __device__ void init(int M, int N, int G_, int c_) { nM = M / BM; nN = N / BM; nwg = nM * nN; G = G_; c = c_; }
    __host__ __device__ bool next(int i, Unit& u) const {
        const long L = (long)i * G + c; if (L >= nwg) return false;
        int wgid = (int)L; { const int q = nwg / NXCD, r = nwg % NXCD, xcd = wgid % NXCD, off = wgid / NXCD; wgid = (xcd < r ? xcd * (q + 1) : r * (q + 1) + (xcd - r) * q) + off; }
        const int nig = WGM * nN, gid = wgid / nig, fm = gid * WGM, gsz = (nM - fm) < WGM ? (nM - fm) : WGM;
        u.pm = fm + ((wgid % nig) % gsz); u.pn = (wgid % nig) / gsz; return true;
    }
    __device__ __forceinline__ void a_ready(const Unit&) const {}
    __device__ __forceinline__ void done(const Unit&) const {}
};

__device__ __forceinline__ unsigned cvt_pk_bf16(float lo, float hi) { unsigned r; asm volatile("v_cvt_pk_bf16_f32 %0, %1, %2" : "=v"(r) : "v"(lo), "v"(hi)); return r; }
typedef float f32x2 __attribute__((ext_vector_type(2)));
__device__ __forceinline__ float fast_sigmoid(float x) { return __builtin_amdgcn_rcpf(1.0f + __expf(-x)); }
__device__ __forceinline__ float bflo(unsigned u) { return __builtin_bit_cast(float, u << 16); }
__device__ __forceinline__ float bfhi(unsigned u) { return __builtin_bit_cast(float, u & 0xffff0000u); }

struct EpiProj {
    static constexpr bool PERM = true, AFTER_DRAIN = false;
    bf16_t *Zb, *XS, *BMb, *CMb, *SBb, *SCb, *SXb, *GT; float* DT;
    __device__ __forceinline__ void operator()(const f32x4 (&acc)[2][2][4][2], const Unit& u, int wr, int wc, int fr, int fq) const {
        const int row0 = u.pm * BM + wr * 64 + fr; const int pn = u.pn;
        if (pn == 44) {
            if (wc == 0) {
#pragma unroll
                for (int ai = 0; ai < 2; ++ai)
#pragma unroll
                    for (int m = 0; m < 4; ++m) { float* rp = DT + (size_t)(row0 + ai * HALF + m * 16) * 32 + 8 * fq;
                        *(f32x4*)(rp) = acc[ai][0][m][0]; *(f32x4*)(rp + 4) = acc[ai][0][m][1]; }
            }
            return;
        }
        bf16_t* base; int ld, colt;
        if (pn < 8) { base = Zb; ld = 2048; colt = pn * 256; }
        else if (pn < 16) { base = XS; ld = 2048; colt = (pn - 8) * 256; }
        else if (pn < 20) { base = BMb; ld = 1024; colt = (pn - 16) * 256; }
        else if (pn < 24) { base = CMb; ld = 1024; colt = (pn - 20) * 256; }
        else if (pn < 28) { base = SBb; ld = 1024; colt = (pn - 24) * 256; }
        else if (pn < 32) { base = SCb; ld = 1024; colt = (pn - 28) * 256; }
        else if (pn < 36) { base = SXb; ld = 1024; colt = (pn - 32) * 256; }
        else { base = GT; ld = 2048; colt = (pn - 36) * 256; }
        const int col0 = colt + wc * 32 + 8 * fq;
#pragma unroll
        for (int ai = 0; ai < 2; ++ai)
#pragma unroll
            for (int m = 0; m < 4; ++m) { bf16_t* rowp = base + (size_t)(row0 + ai * HALF + m * 16) * ld + col0;
#pragma unroll
                for (int bj = 0; bj < 2; ++bj) { const f32x4 v0 = acc[ai][bj][m][0], v1 = acc[ai][bj][m][1];
                    u32x4 w; w.x = cvt_pk_bf16(v0[0], v0[1]); w.y = cvt_pk_bf16(v0[2], v0[3]); w.z = cvt_pk_bf16(v1[0], v1[1]); w.w = cvt_pk_bf16(v1[2], v1[3]);
                    *(u32x4*)(rowp + bj * HALF) = w; } }
    }
};
struct EpiBf16Plain {
    static constexpr bool PERM = true, AFTER_DRAIN = false;
    bf16_t* O; int ldc;
    __device__ __forceinline__ void operator()(const f32x4 (&acc)[2][2][4][2], const Unit& u, int wr, int wc, int fr, int fq) const {
        const int row0 = u.pm * BM + wr * 64 + fr; const int col0 = u.pn * BM + wc * 32 + 8 * fq;
#pragma unroll
        for (int ai = 0; ai < 2; ++ai)
#pragma unroll
            for (int m = 0; m < 4; ++m) { bf16_t* rowp = O + (size_t)(row0 + ai * HALF + m * 16) * ldc + col0;
#pragma unroll
                for (int bj = 0; bj < 2; ++bj) { const f32x4 v0 = acc[ai][bj][m][0], v1 = acc[ai][bj][m][1];
                    u32x4 w; w.x = cvt_pk_bf16(v0[0], v0[1]); w.y = cvt_pk_bf16(v0[2], v0[3]); w.z = cvt_pk_bf16(v1[0], v1[1]); w.w = cvt_pk_bf16(v1[2], v1[3]);
                    *(u32x4*)(rowp + bj * HALF) = w; } }
    }
};
struct EpiF32Plain {
    static constexpr bool PERM = false, AFTER_DRAIN = false;
    float* C; int ldc;
    __device__ __forceinline__ void operator()(const f32x4 (&acc)[2][2][4][2], const Unit& u, int wr, int wc, int fr, int fq) const {
        const int row0 = u.pm * BM + wr * 64 + fr, col0 = u.pn * BM + wc * 32 + 4 * fq;
#pragma unroll
        for (int ai = 0; ai < 2; ++ai)
#pragma unroll
            for (int m = 0; m < 4; ++m) { float* rowp = C + (size_t)(row0 + ai * HALF + m * 16) * ldc + col0;
#pragma unroll
                for (int bj = 0; bj < 2; ++bj)
#pragma unroll
                    for (int n = 0; n < 2; ++n) *(f32x4*)(rowp + bj * HALF + n * 16) = acc[ai][bj][m][n]; }
    }
};
struct EpiMerge {
    static constexpr bool PERM = false, AFTER_DRAIN = false;
    const float* YS; const bf16_t* GT; bf16_t* O;
    __device__ __forceinline__ void operator()(const f32x4 (&acc)[2][2][4][2], const Unit& u, int wr, int wc, int fr, int fq) const {
        const int row0 = u.pm * BM + wr * 64 + fr, col0 = u.pn * BM + wc * 32 + 4 * fq;
#pragma unroll
        for (int ai = 0; ai < 2; ++ai)
#pragma unroll
            for (int m = 0; m < 4; ++m) { const size_t row = (size_t)(row0 + ai * HALF + m * 16);
#pragma unroll
                for (int bj = 0; bj < 2; ++bj)
#pragma unroll
                    for (int n = 0; n < 2; ++n) { const int col = col0 + bj * HALF + n * 16;
                        const f32x4 ys = *(const f32x4*)(YS + row * 1024 + col);
                        const uint2 g1 = *(const uint2*)(GT + row * 2048 + col), g2 = *(const uint2*)(GT + row * 2048 + 1024 + col);
                        const f32x4 a = acc[ai][bj][m][n];
                        const float o0 = fast_sigmoid(bflo(g1.x)) * ys[0] + fast_sigmoid(bflo(g2.x)) * a[0];
                        const float o1 = fast_sigmoid(bfhi(g1.x)) * ys[1] + fast_sigmoid(bfhi(g2.x)) * a[1];
                        const float o2 = fast_sigmoid(bflo(g1.y)) * ys[2] + fast_sigmoid(bflo(g2.y)) * a[2];
                        const float o3 = fast_sigmoid(bfhi(g1.y)) * ys[3] + fast_sigmoid(bfhi(g2.y)) * a[3];
                        uint2 w; w.x = cvt_pk_bf16(o0, o1); w.y = cvt_pk_bf16(o2, o3);
                        *(uint2*)(O + row * 1024 + col) = w; } }
    }
};
struct EpiWo {
    static constexpr bool PERM = false, AFTER_DRAIN = false;
    const float* X; float* H1; int soff;
    __device__ __forceinline__ void operator()(const f32x4 (&acc)[2][2][4][2], const Unit& u, int wr, int wc, int fr, int fq) const {
        const int row0 = u.pm * BM + wr * 64 + fr, col0 = u.pn * BM + wc * 32 + 4 * fq;
#pragma unroll
        for (int ai = 0; ai < 2; ++ai)
#pragma unroll
            for (int m = 0; m < 4; ++m) { const int r = row0 + ai * HALF + m * 16; const size_t xr = (size_t)((r >> 11) * 4096 + soff + (r & 2047));
                const float* xp = X + xr * 1024 + col0; float* hp = H1 + (size_t)r * 1024 + col0;
#pragma unroll
                for (int bj = 0; bj < 2; ++bj)
#pragma unroll
                    for (int n = 0; n < 2; ++n) *(f32x4*)(hp + bj * HALF + n * 16) = *(const f32x4*)(xp + bj * HALF + n * 16) + acc[ai][bj][m][n]; }
    }
};
template <class Epi, class Sched, bool ALIGN_EPI = false, bool SP2 = false>
__device__ __forceinline__ void gemm_phase(PG8_LAS unsigned char* lds, const Gemm g, const Sched& S, const Epi& E) {
    int tid_ = threadIdx.x; asm volatile("" : "+v"(tid_)); const int tid = tid_, wid = __builtin_amdgcn_readfirstlane(tid >> 6), lane = tid & 63, wr = wid >> 2, wc = wid & 3, fr = lane & 15, fq = lane >> 4;
    const int K = g.K, nt = K / BK;
    unsigned voffA[2], voffB[2];
#pragma unroll
    for (int i = 0; i < 2; ++i) { int R, C; stage_rc(tid * 16 + i * 8192, R, C); const int Rb = Epi::PERM ? ((R & ~31) + perm32(R & 31)) : R;
        voffA[i] = (unsigned)(R * K + C) * 2u; voffB[i] = (unsigned)(Rb * K + C) * 2u; }
    const size_t kstep = (size_t)(BK * 2);
    const size_t hstep = (size_t)HALF * K * 2;
    const size_t tstep = 2 * hstep;
    const unsigned ldsw = (unsigned)wid * 1024u;
    const int aoff = lds_byte(wr * 64 + fr, fq * 8), boff = lds_byte(wc * 32 + fr, fq * 8);
#define PG8_SA(b, h) (((b) * 2 + (h)) * HTB)
#define PG8_SB(b, h) ((4 + (b) * 2 + (h)) * HTB)
#define PG8_STAGE(bufoff, gbase, voff) do { _Pragma("unroll") for (int _i = 0; _i < 2; ++_i) \
        __builtin_amdgcn_global_load_lds((const unsigned*)((const char*)(gbase) + (voff)[_i]), (PG8_LAS unsigned*)(lds + (bufoff) + ldsw + _i * 8192), 16, 0, 0); } while (0)
#define PG8_LDA(dst, b, h) do { _Pragma("unroll") for (int m = 0; m < 4; ++m) _Pragma("unroll") for (int k = 0; k < 2; ++k) dst[m][k] = *(const PG8_LAS bf16x8*)(lds + PG8_SA(b, h) + aoff + m * 2048 + k * 1024); } while (0)
#define PG8_LDB(dst, b, h) do { _Pragma("unroll") for (int n = 0; n < 2; ++n) _Pragma("unroll") for (int k = 0; k < 2; ++k) dst[n][k] = *(const PG8_LAS bf16x8*)(lds + PG8_SB(b, h) + boff + n * 2048 + k * 1024); } while (0)
#define PG8_MMA(ai, bj, At, Bt) do { __builtin_amdgcn_s_setprio(1); _Pragma("unroll") for (int m = 0; m < 4; ++m) _Pragma("unroll") for (int n = 0; n < 2; ++n) _Pragma("unroll") for (int k = 0; k < 2; ++k) \
        acc[ai][bj][m][n] = __builtin_amdgcn_mfma_f32_16x16x32_bf16(Bt[n][k], At[m][k], acc[ai][bj][m][n], 0, 0, 0); __builtin_amdgcn_s_setprio(0); } while (0)
#define PG8_WAIT_V(n) asm volatile("s_waitcnt vmcnt(" #n ")" ::: "memory")
#define PG8_WAIT_L(n) asm volatile("s_waitcnt lgkmcnt(" #n ")" ::: "memory")
#define PG8_BAR __builtin_amdgcn_s_barrier()
#define PG8_SCHED __builtin_amdgcn_sched_barrier(0)
    Unit cur, nxt; int ui = 0;
    if (!S.next(0, cur)) return;
    f32x4 acc[2][2][4][2];
#pragma unroll
    for (int a = 0; a < 2; ++a)
#pragma unroll
        for (int b = 0; b < 2; ++b)
#pragma unroll
            for (int m = 0; m < 4; ++m)
#pragma unroll
                for (int n = 0; n < 2; ++n) acc[a][b][m][n] = (f32x4){0.f, 0.f, 0.f, 0.f};
    bf16x8 At[4][2], B0[2][2], B1[2][2];
    const char* cA = (const char*)g.A + (size_t)cur.pm * tstep; const char* cB = (const char*)g.Bt + (size_t)cur.pn * tstep;
    S.a_ready(cur);
    if constexpr (SP2) {
        PG8_STAGE(PG8_SB(0, 0), cB, voffB); PG8_STAGE(PG8_SB(0, 1), cB + hstep, voffB); PG8_STAGE(PG8_SA(0, 0), cA, voffA); PG8_STAGE(PG8_SA(0, 1), cA + hstep, voffA);
        if (wr == 1) PG8_BAR;
        PG8_WAIT_V(2); PG8_BAR;
        PG8_STAGE(PG8_SB(1, 0), cB + kstep, voffB); PG8_STAGE(PG8_SA(1, 0), cA + kstep, voffA); PG8_STAGE(PG8_SB(1, 1), cB + hstep + kstep, voffB);
        PG8_WAIT_V(6); PG8_BAR;
    } else {
        PG8_STAGE(PG8_SB(0, 0), cB, voffB); PG8_STAGE(PG8_SA(0, 0), cA, voffA); PG8_STAGE(PG8_SB(0, 1), cB + hstep, voffB); PG8_STAGE(PG8_SA(0, 1), cA + hstep, voffA);
        if (wr == 1) PG8_BAR;
        PG8_WAIT_V(4); PG8_BAR;
        PG8_STAGE(PG8_SB(1, 0), cB + kstep, voffB); PG8_STAGE(PG8_SA(1, 0), cA + kstep, voffA); PG8_STAGE(PG8_SB(1, 1), cB + hstep + kstep, voffB);
        PG8_WAIT_V(6); PG8_BAR;
    }
    for (;;) {
        const bool has_next = S.next(ui + 1, nxt);
        const char* nA = has_next ? (const char*)g.A + (size_t)nxt.pm * tstep : cA; const char* nB = has_next ? (const char*)g.Bt + (size_t)nxt.pn * tstep : cB;
        for (int t = 0; t < nt; t += 2) {
            const bool last = (t == nt - 2);
            const char* a1 = cA + (size_t)(t + 1) * kstep;
            const char* a2 = last ? nA : cA + (size_t)(t + 2) * kstep; const char* b2 = last ? nB : cB + (size_t)(t + 2) * kstep;
            const char* a3 = a2 + kstep; const char* b3 = b2 + kstep;
            if (last && has_next) S.a_ready(nxt);
            if constexpr (SP2) {
            PG8_LDB(B0, 0, 0); PG8_LDB(B1, 0, 1); PG8_SCHED; PG8_LDA(At, 0, 0); PG8_STAGE(PG8_SA(1, 1), a1 + hstep, voffA);
            PG8_WAIT_V(8); PG8_WAIT_L(0); PG8_BAR; PG8_MMA(0, 0, At, B0); PG8_MMA(0, 1, At, B1); PG8_BAR; PG8_SCHED;
            PG8_LDA(At, 0, 1); PG8_STAGE(PG8_SB(0, 0), b2, voffB); PG8_STAGE(PG8_SB(0, 1), b2 + hstep, voffB); PG8_STAGE(PG8_SA(0, 0), a2, voffA);
            PG8_WAIT_V(8); PG8_WAIT_L(0); PG8_BAR; PG8_MMA(1, 0, At, B0); PG8_MMA(1, 1, At, B1); PG8_BAR; PG8_SCHED;
            PG8_LDB(B0, 1, 0); PG8_LDB(B1, 1, 1); PG8_SCHED; PG8_LDA(At, 1, 0); PG8_STAGE(PG8_SA(0, 1), a2 + hstep, voffA);
            PG8_WAIT_V(8); PG8_WAIT_L(0); PG8_BAR; PG8_MMA(0, 0, At, B0); PG8_MMA(0, 1, At, B1); PG8_BAR; PG8_SCHED;
            PG8_LDA(At, 1, 1); PG8_STAGE(PG8_SB(1, 0), b3, voffB); PG8_STAGE(PG8_SB(1, 1), b3 + hstep, voffB); PG8_STAGE(PG8_SA(1, 0), a3, voffA);
            PG8_WAIT_V(8); PG8_WAIT_L(0); PG8_BAR; PG8_MMA(1, 0, At, B0); PG8_MMA(1, 1, At, B1); PG8_BAR; PG8_SCHED;
            } else {
            PG8_LDB(B0, 0, 0); PG8_SCHED; PG8_LDA(At, 0, 0); PG8_STAGE(PG8_SA(1, 1), a1 + hstep, voffA);
            PG8_WAIT_L(8); PG8_BAR; PG8_WAIT_L(0); PG8_MMA(0, 0, At, B0); PG8_BAR; PG8_SCHED;
            PG8_LDB(B1, 0, 1); PG8_STAGE(PG8_SB(0, 0), b2, voffB);
            PG8_BAR; PG8_WAIT_L(0); PG8_MMA(0, 1, At, B1); PG8_BAR;
            PG8_LDA(At, 0, 1); PG8_STAGE(PG8_SA(0, 0), a2, voffA);
            PG8_BAR; PG8_WAIT_L(0); PG8_MMA(1, 0, At, B0); PG8_BAR; PG8_SCHED;
            PG8_STAGE(PG8_SB(0, 1), b2 + hstep, voffB);
            PG8_WAIT_V(6); PG8_BAR; PG8_MMA(1, 1, At, B1); PG8_BAR;
            PG8_LDB(B0, 1, 0); PG8_SCHED; PG8_LDA(At, 1, 0); PG8_STAGE(PG8_SA(0, 1), a2 + hstep, voffA);
            PG8_WAIT_L(8); PG8_BAR; PG8_WAIT_L(0); PG8_MMA(0, 0, At, B0); PG8_BAR; PG8_SCHED;
            PG8_LDB(B1, 1, 1); PG8_STAGE(PG8_SB(1, 0), b3, voffB);
            PG8_BAR; PG8_WAIT_L(0); PG8_MMA(0, 1, At, B1); PG8_BAR;
            PG8_LDA(At, 1, 1); PG8_STAGE(PG8_SA(1, 0), a3, voffA);
            PG8_BAR; PG8_WAIT_L(0); PG8_MMA(1, 0, At, B0); PG8_BAR; PG8_SCHED;
            PG8_STAGE(PG8_SB(1, 1), b3 + hstep, voffB);
            PG8_WAIT_V(6); PG8_BAR; PG8_MMA(1, 1, At, B1); PG8_BAR;
            }
        }
        if constexpr (ALIGN_EPI) { if (wr == 0) PG8_BAR; }
        if constexpr (!Epi::AFTER_DRAIN) { E(acc, cur, wr, wc, fr, fq); S.done(cur); }
        if (!has_next) break;
#pragma unroll
        for (int a = 0; a < 2; ++a)
#pragma unroll
            for (int b = 0; b < 2; ++b)
#pragma unroll
                for (int m = 0; m < 4; ++m)
#pragma unroll
                    for (int n = 0; n < 2; ++n) acc[a][b][m][n] = (f32x4){0.f, 0.f, 0.f, 0.f};
        cur = nxt; cA = nA; cB = nB; ++ui;
        if constexpr (ALIGN_EPI) { if (wr == 1) PG8_BAR; }
    }
    PG8_WAIT_V(0);
    if constexpr (!ALIGN_EPI) { if (wr == 0) PG8_BAR; }
    PG8_BAR;
    if constexpr (Epi::AFTER_DRAIN) { E.fused(acc, cur, wr, wc, fr, fq, lds, wid, lane); S.done(cur); }
#undef PG8_SA
#undef PG8_SB
#undef PG8_STAGE
#undef PG8_LDA
#undef PG8_LDB
#undef PG8_MMA
#undef PG8_WAIT_V
#undef PG8_WAIT_L
#undef PG8_BAR
#undef PG8_SCHED
}
}

#define GAS __attribute__((address_space(1)))
#define LAS __attribute__((address_space(3)))
typedef unsigned short bf16;
typedef unsigned v4u __attribute__((ext_vector_type(4)));
typedef unsigned v2u __attribute__((ext_vector_type(2)));
typedef float f32x4 __attribute__((ext_vector_type(4)));
typedef float f32x16 __attribute__((ext_vector_type(16)));
typedef short bf16x8 __attribute__((ext_vector_type(8)));
#define LDS_WAIT() asm volatile("s_waitcnt lgkmcnt(0)" ::: "memory")
#define VM_WAIT() asm volatile("s_waitcnt vmcnt(0)" ::: "memory")

constexpr int NB = 8, SEQ = 4096, DM = 1024, NSLICE = 2, SL = SEQ / NSLICE, RS = NB * SL, RP = RS + 256;
constexpr int NPROJ = 11520;
constexpr float EPS = 1e-6f;
constexpr int NWAVES = 8;
constexpr size_t MiB = 1u << 20;
constexpr size_t WS_CTL = 0, CTL_ZERO_BYTES = 1 * MiB;
constexpr size_t WS_WIN = 1 * MiB;
constexpr size_t WS_WSSD = WS_WIN + 23592960;
constexpr size_t WS_WSC = WS_WSSD + 4 * MiB;
constexpr size_t WS_WO = WS_WSC + 2 * MiB;
constexpr size_t WS_WQ = WS_WO + 2 * MiB;
constexpr size_t WS_SK = WS_WQ + 4 * MiB;
constexpr size_t WS_EU = WS_SK + MiB / 2;
constexpr size_t WS_EV = WS_EU + 16 * MiB;
constexpr size_t WS_SU = WS_EV + 16 * MiB;
constexpr size_t WS_SV = WS_SU + MiB / 4;
constexpr size_t WS_STATE = WS_SV + MiB / 4;
constexpr size_t WS_HALO = WS_STATE + 8 * MiB;
constexpr size_t WS_SCH = WS_HALO + MiB / 2;
constexpr size_t WS_U0 = WS_SCH + MiB / 2;
constexpr size_t SZ_R1 = (size_t)RP * 1024 * 2;
constexpr size_t WS_Z = WS_U0 + SZ_R1;
constexpr size_t WS_XS = WS_Z + 2 * SZ_R1;
constexpr size_t WS_BM = WS_XS + 2 * SZ_R1;
constexpr size_t WS_CM = WS_BM + SZ_R1;
constexpr size_t WS_DT = WS_CM + SZ_R1;
constexpr size_t WS_SB = WS_DT + 5 * MiB / 2;
constexpr size_t WS_SC = WS_SB + SZ_R1;
constexpr size_t WS_SX = WS_SC + SZ_R1;
constexpr size_t WS_GT = WS_SX + SZ_R1;
constexpr size_t WS_END = WS_GT + 2 * SZ_R1;
static_assert(WS_END <= 512 * MiB, "workspace map exceeds 512 MiB");
static_assert((size_t)RP * 32 * 4 <= 5 * MiB / 2, "dt");
constexpr int CW_BAR = 4096;
constexpr int LDS_BYTES = 163840;
constexpr int MISC_OFF = LDS_BYTES - 256;

__device__ __forceinline__ unsigned pk2(float lo, float hi) { unsigned r; asm("v_cvt_pk_bf16_f32 %0, %1, %2" : "=v"(r) : "v"(lo), "v"(hi)); return r; }
__device__ __forceinline__ float bf2f(bf16 v) { return __builtin_bit_cast(float, (unsigned)v << 16); }
__device__ __forceinline__ bf16 f2bf1(float f) { return (bf16)(pk2(f, 0.f) & 0xffffu); }
__device__ __forceinline__ float blo(unsigned u) { return __builtin_bit_cast(float, u << 16); }
__device__ __forceinline__ float bhi(unsigned u) { return __builtin_bit_cast(float, u & 0xffff0000u); }
__device__ __forceinline__ float siluf(float x) { return x * __builtin_amdgcn_rcpf(1.0f + __expf(-x)); }
__device__ __forceinline__ float wave_sum(float v) {
#pragma unroll
    for (int o = 1; o < 64; o <<= 1) v += __shfl_xor(v, o);
    return v;
}
#define XB_TMO      128
#define XB_XCNT(j)  (256  + 64 * (j))
#define XB_XSUB(j)  (1280 + 64 * (j))
#define XB_XGEN(j)  (2304 + 64 * (j))
#define XB_TOP      3328
#define XB_TOPGEN   3392
#define XCD_BAR_WORDS 3456
#define XB_SPIN_CAP (1u << 18)

__device__ __forceinline__ unsigned xb_ld(unsigned* p)              { return __hip_atomic_load(p, __ATOMIC_RELAXED, __HIP_MEMORY_SCOPE_AGENT); }
__device__ __forceinline__ unsigned xb_add(unsigned* p, unsigned v) { return __hip_atomic_fetch_add(p, v, __ATOMIC_RELAXED, __HIP_MEMORY_SCOPE_AGENT); }
__device__ __forceinline__ unsigned xb_xcc_id() { return (unsigned)__builtin_amdgcn_s_getreg((3 << 11) | 20) & 0xFu; }
#define XB_SPIN(cond, bar) do { unsigned _sp = 0; while (cond) { __builtin_amdgcn_s_sleep(1); \
    if ((++_sp & 255u) == 0u) { if (xb_ld(&(bar)[XB_TMO])) break; if (_sp > XB_SPIN_CAP) { atomicAdd(&(bar)[XB_TMO], 1u); break; } } } } while (0)

struct XcdBarrier {
    unsigned* bar; unsigned x;
    volatile LAS unsigned* st;
};

__device__ __forceinline__ XcdBarrier xcd_barrier_post(unsigned* bar, volatile LAS unsigned* st) {
    XcdBarrier b; b.bar = bar; b.x = xb_xcc_id(); b.st = st;
    if (threadIdx.x == 0) (void)xb_add(&bar[XB_XCNT(b.x)], 1u);
    return b;
}
__device__ __forceinline__ void xcd_barrier_complete(unsigned* bar, unsigned x, unsigned& nloc, unsigned& nx) {
    const unsigned G = gridDim.x * gridDim.y * gridDim.z;
    unsigned sum, cnt, mine, sp = 0u;
    for (;;) {
        sum = 0u; cnt = 0u; mine = 0u;
#pragma unroll
        for (unsigned j = 0; j < 16; ++j) { const unsigned c = xb_ld(&bar[XB_XCNT(j)]); sum += c; cnt += (c > 0u) ? 1u : 0u; mine = (j == x) ? c : mine; }
        if (sum == G) break;
        __builtin_amdgcn_s_sleep(1);
        if ((++sp & 255u) == 0u) { if (xb_ld(&bar[XB_TMO])) break; if (sp > XB_SPIN_CAP) { atomicAdd(&bar[XB_TMO], 1u); break; } }
    }
    nloc = mine > 0u ? mine : 1u; nx = cnt > 0u ? cnt : 1u;
}

__device__ __forceinline__ void xcd_barrier(const XcdBarrier& b) {
    asm volatile("s_waitcnt vmcnt(0)" ::: "memory");
    __syncthreads();
    if (threadIdx.x == 0) {
        unsigned* bar = b.bar;
        __builtin_amdgcn_s_waitcnt(0);
        unsigned nloc = b.st[0], nx = b.st[1];
        if (nloc == 0u) { xcd_barrier_complete(bar, b.x, nloc, nx); b.st[0] = nloc; b.st[1] = nx; }
        const unsigned old = xb_add(&bar[XB_XSUB(b.x)], 1u);
        const unsigned gen = old / nloc;
        if (old + 1u == (gen + 1u) * nloc) {
            __builtin_amdgcn_fence(__ATOMIC_RELEASE, "agent");
            asm volatile("s_waitcnt vmcnt(0)" ::: "memory");
            const unsigned og = xb_add(&bar[XB_TOP], 1u);
            const unsigned tg = og / nx;
            if (og + 1u == (tg + 1u) * nx) xb_add(&bar[XB_TOPGEN], 1u);
            else XB_SPIN(xb_ld(&bar[XB_TOPGEN]) == tg, bar);
            __builtin_amdgcn_fence(__ATOMIC_ACQUIRE, "agent");
            xb_add(&bar[XB_XGEN(b.x)], 1u);
            asm volatile("s_waitcnt vmcnt(0)" ::: "memory");
        } else {
            XB_SPIN(xb_ld(&bar[XB_XGEN(b.x)]) == gen, bar);
            __builtin_amdgcn_fence(__ATOMIC_ACQUIRE, "agent");
            asm volatile("s_waitcnt vmcnt(0)" ::: "memory");
        }
    }
    __syncthreads();
}


struct Ctx {
    LAS unsigned char* lds;
    int tid, lane, wave, vcu, G;
    float* out;
    unsigned char* ws;
};
struct Args { const float* in[20]; float* out; unsigned char* ws; int ph_lo, ph_hi; };
static_assert(sizeof(Args) == 22 * 8 + 8, "Args has no padding");
#define GIN(A_, i_) ((const float*)(const GAS float*)(A_).in[i_])
__device__ __forceinline__ int opq(int v) { asm volatile("" : "+v"(v)); return v; }
__device__ __forceinline__ unsigned char* opq_p(unsigned char* p) { GAS unsigned char* q = (GAS unsigned char*)p; asm volatile("" : "+s"(q)); return (unsigned char*)q; }
enum { I_X = 0, I_META, I_LNMIX, I_WIN, I_CONVW, I_CONVB, I_DTB, I_ALOG, I_D, I_NORM, I_WSSD, I_SCCW, I_WSC, I_WO, I_LNFFN, I_WQ, I_SK, I_PU, I_PV, I_LNF };

__device__ __forceinline__ void tr_item(const float* W, int ldw, int src0, int k0, bf16* WT, int K, int n0, LAS float* scr, int lane) {
#pragma unroll 8
    for (int i = 0; i < 32; ++i) { const int kk = 2 * i + (lane >> 5); scr[kk * 33 + (lane & 31)] = (src0 >= 0) ? W[(size_t)(k0 + kk) * ldw + src0 + (lane & 31)] : 0.f; }
    LDS_WAIT(); asm volatile("" ::: "memory");
    const int c = lane & 7;
#pragma unroll
    for (int j = 0; j < 4; ++j) { const int n = (lane >> 3) + 8 * j; const LAS float* s = scr + (8 * c) * 33 + n;
        v4u o; o.x = pk2(s[0 * 33], s[1 * 33]); o.y = pk2(s[2 * 33], s[3 * 33]); o.z = pk2(s[4 * 33], s[5 * 33]); o.w = pk2(s[6 * 33], s[7 * 33]);
        *(v4u*)(WT + (size_t)(n0 + n) * K + k0 + 8 * c) = o; }
    LDS_WAIT(); asm volatile("" ::: "memory");
}
__device__ __forceinline__ void cvt_item(const float* src, bf16* dst, int lane) {
#pragma unroll
    for (int i = 0; i < 8; ++i) { const f32x4 a = *(const f32x4*)(src + i * 512 + lane * 8), b = *(const f32x4*)(src + i * 512 + lane * 8 + 4);
        v4u o; o.x = pk2(a[0], a[1]); o.y = pk2(a[2], a[3]); o.z = pk2(b[0], b[1]); o.w = pk2(b[2], b[3]);
        *(v4u*)(dst + i * 512 + lane * 8) = o; }
}
template <bool SLICED> __device__ __forceinline__ void fp8_row(const float* src, unsigned char* dst, float* scale, int e, int lane) {
    f32x4 v[4]; float am = 0.f;
#pragma unroll
    for (int j = 0; j < 4; ++j) { v[j] = *(const f32x4*)(src + (size_t)e * 1024 + 4 * lane + 256 * j); am = fmaxf(am, fmaxf(fmaxf(fabsf(v[j][0]), fabsf(v[j][1])), fmaxf(fabsf(v[j][2]), fabsf(v[j][3])))); }
#pragma unroll
    for (int o = 1; o < 64; o <<= 1) am = fmaxf(am, __shfl_xor(am, o));
    const float s = (am > 0.f) ? am * (1.0f / 440.0f) : 1.0f, inv = 1.0f / s;
    if (lane == 0) scale[e] = s;
#pragma unroll
    for (int j = 0; j < 4; ++j) { int p = __builtin_amdgcn_cvt_pk_fp8_f32(v[j][0] * inv, v[j][1] * inv, 0, false); p = __builtin_amdgcn_cvt_pk_fp8_f32(v[j][2] * inv, v[j][3] * inv, p, true);
        const int c = 4 * lane + 256 * j;
        if (SLICED) *(int*)(dst + ((size_t)(c >> 7) * 16384 + e) * 128 + (c & 127)) = p;
        else *(int*)(dst + (size_t)e * 1024 + c) = p; }
}
__device__ __forceinline__ void rms_row_bf16(const float* xrow, const float* g, bf16* orow, int lane) {
    uint2* o8 = (uint2*)orow + lane;
    if (xrow == nullptr) {
#pragma unroll
        for (int j = 0; j < 4; ++j) o8[64 * j] = make_uint2(0u, 0u);
        return;
    }
    const f32x4* xr = (const f32x4*)xrow + lane; const f32x4* gr = (const f32x4*)g + lane;
    f32x4 v[4]; float s = 0.f;
#pragma unroll
    for (int j = 0; j < 4; ++j) { v[j] = xr[64 * j]; s += (v[j][0] * v[j][0] + v[j][1] * v[j][1]) + (v[j][2] * v[j][2] + v[j][3] * v[j][3]); }
    const float r = rsqrtf(wave_sum(s) * (1.f / 1024.f) + EPS);
#pragma unroll
    for (int j = 0; j < 4; ++j) { const f32x4 gg = gr[64 * j]; o8[64 * j] = make_uint2(pk2(v[j][0] * r * gg[0], v[j][1] * r * gg[1]), pk2(v[j][2] * r * gg[2], v[j][3] * r * gg[3])); }
}
__device__ __forceinline__ const float* u0_src(const Args& A, int sl, int r) {
    if (r < RS) return GIN(A, I_X) + ((size_t)(r >> 11) * SEQ + sl * SL + (r & (SL - 1))) * DM;
    const int l = r - RS;
    if (l >= 48 && l < 64) return GIN(A, I_META) + (size_t)(l - 48) * DM;
    return nullptr;
}
__device__ __forceinline__ void phase_prep(Ctx& C, const Args& A) {
    LAS float* scr = (LAS float*)(C.lds + C.wave * 16384);
    const int lane = opq(C.tid) & 63;
    const int gw = C.vcu * NWAVES + C.wave, NGW = C.G * NWAVES;
    unsigned char* ws = opq_p(C.ws);
    constexpr int N_WIN = 16 * 360, N_SSD = 32 * 32, N_SC = 16 * 32, N_WO = 16 * 32, N_WQ = 16 * 64, N_SKC = 64, N_EC = 16384, N_U0 = RP;
    constexpr int NITEMS = N_WIN + N_SSD + N_SC + N_WO + N_WQ + N_SKC + 2 * N_EC + N_U0;
    for (int it = gw; it < NITEMS; it += NGW) {
        int r = it;
        if (r < N_WIN) { const int kb = r / 360, nb = r % 360, n0 = nb * 32;
            const int src0 = (n0 < 6144) ? n0 : (n0 < 11264 ? n0 + 32 : (n0 < 11296 ? n0 - 11264 + 6144 : -1));
            tr_item(GIN(A, I_WIN), 11296, src0, kb * 64, (bf16*)(ws + WS_WIN), 1024, n0, scr, lane); continue; } r -= N_WIN;
        if (r < N_SSD) { const int kb = r / 32, nb = r % 32; tr_item(GIN(A, I_WSSD), 1024, nb * 32, kb * 64, (bf16*)(ws + WS_WSSD), 2048, nb * 32, scr, lane); continue; } r -= N_SSD;
        if (r < N_SC) { const int kb = r / 32, nb = r % 32; tr_item(GIN(A, I_WSC), 1024, nb * 32, kb * 64, (bf16*)(ws + WS_WSC), 1024, nb * 32, scr, lane); continue; } r -= N_SC;
        if (r < N_WO) { const int kb = r / 32, nb = r % 32; tr_item(GIN(A, I_WO), 1024, nb * 32, kb * 64, (bf16*)(ws + WS_WO), 1024, nb * 32, scr, lane); continue; } r -= N_WO;
        if (r < N_WQ) { const int kb = r / 64, nb = r % 64; tr_item(GIN(A, I_WQ), 2048, nb * 32, kb * 64, (bf16*)(ws + WS_WQ), 1024, nb * 32, scr, lane); continue; } r -= N_WQ;
        if (r < N_SKC) { cvt_item(GIN(A, I_SK) + (size_t)r * 4096, (bf16*)(ws + WS_SK) + (size_t)r * 4096, lane); continue; } r -= N_SKC;
        if (r < N_EC) { fp8_row<true>(GIN(A, I_PU), ws + WS_EU, (float*)(ws + WS_SU), r, lane); continue; } r -= N_EC;
        if (r < N_EC) { fp8_row<true>(GIN(A, I_PV), ws + WS_EV, (float*)(ws + WS_SV), r, lane); continue; } r -= N_EC;
        rms_row_bf16(u0_src(A, 0, r), GIN(A, I_LNMIX), (bf16*)(ws + WS_U0) + (size_t)r * DM, lane);
    }
}

constexpr int SC_RAWS = 328;
constexpr int SC_RAW = 0, SC_M = 44032, SC_CC = 53248, SC_BC = 70656, SC_BCT = 88064, SC_XST = 106496, SC_XDTT = 115712, SC_XDTET = 124928, SC_STB = 134144, SC_ACUM = 151552, SC_DTV = 152064;
constexpr int SC_S64 = 72, SC_S128 = 136;
static_assert(SC_DTV + 512 <= MISC_OFF, "scan LDS map");

__device__ __forceinline__ void phase_scan(Ctx& C, const Args& A, int sl) {
    const int tid = opq(C.tid), lane = tid & 63, wave = C.wave, fr = lane & 15, fq = lane >> 4;
    const int bh = C.vcu, b = bh >> 5, h = bh & 31, g = h >> 2;
    unsigned char* ws = opq_p(C.ws);
    bf16* XS = (bf16*)(ws + WS_XS); const bf16* BMp = (const bf16*)(ws + WS_BM); const bf16* CMp = (const bf16*)(ws + WS_CM); const float* DTp = (const float*)(ws + WS_DT);
    LAS bf16* RAW = (LAS bf16*)(C.lds + SC_RAW); LAS bf16* Mm = (LAS bf16*)(C.lds + SC_M); LAS bf16* CC = (LAS bf16*)(C.lds + SC_CC); LAS bf16* BC = (LAS bf16*)(C.lds + SC_BC);
    LAS bf16* BCT = (LAS bf16*)(C.lds + SC_BCT); LAS bf16* XST = (LAS bf16*)(C.lds + SC_XST); LAS bf16* XDTT = (LAS bf16*)(C.lds + SC_XDTT); LAS bf16* XDTET = (LAS bf16*)(C.lds + SC_XDTET);
    LAS bf16* STB = (LAS bf16*)(C.lds + SC_STB); LAS float* ACUM = (LAS float*)(C.lds + SC_ACUM); LAS float* DTV = (LAS float*)(C.lds + SC_DTV);
    const int chx = tid & 63, rbx = tid >> 6, chb = tid & 127, rbb = tid >> 7;
    const float* cw = GIN(A, I_CONVW); const float* cb_ = GIN(A, I_CONVB);
    float wx[4], wB[4], wC[4];
    { const f32x4 t = *(const f32x4*)(cw + (size_t)(h * 64 + chx) * 4); wx[0] = t[0]; wx[1] = t[1]; wx[2] = t[2]; wx[3] = t[3]; }
    { const f32x4 t = *(const f32x4*)(cw + (size_t)(2048 + g * 128 + chb) * 4); wB[0] = t[0]; wB[1] = t[1]; wB[2] = t[2]; wB[3] = t[3]; }
    { const f32x4 t = *(const f32x4*)(cw + (size_t)(3072 + g * 128 + chb) * 4); wC[0] = t[0]; wC[1] = t[1]; wC[2] = t[2]; wC[3] = t[3]; }
    const float bx = cb_[h * 64 + chx], bB = cb_[2048 + g * 128 + chb], bC = cb_[3072 + g * 128 + chb];
    const float dtb = GIN(A, I_DTB)[h], aneg = -__expf(GIN(A, I_ALOG)[h]), dsk = GIN(A, I_D)[h];
    const int tr = wave & 3, tc0 = (wave >> 2) * 2;
    const int tp = wave & 3, tn0 = (wave >> 2) * 4;
    f32x4 st[4];
    float* STATE = (float*)(ws + WS_STATE) + (size_t)bh * 64 * 128;
    bf16* HALO = (bf16*)(ws + WS_HALO) + (size_t)bh * 3 * 320;
    if (sl == 0) {
#pragma unroll
        for (int j = 0; j < 4; ++j) st[j] = (f32x4){0.f, 0.f, 0.f, 0.f};
        for (int i = tid; i < 3 * SC_RAWS; i += 512) RAW[i] = 0;
    } else {
#pragma unroll
        for (int j = 0; j < 4; ++j)
#pragma unroll
            for (int i = 0; i < 4; ++i) st[j][i] = STATE[(tp * 16 + fq * 4 + i) * 128 + (tn0 + j) * 16 + fr];
        for (int i = tid; i < 3 * 320; i += 512) RAW[(i / 320) * SC_RAWS + (i % 320)] = HALO[i];
    }
#pragma unroll
    for (int j = 0; j < 4; ++j)
#pragma unroll
        for (int i = 0; i < 4; ++i) STB[(tp * 16 + fq * 4 + i) * SC_S128 + (tn0 + j) * 16 + fr] = f2bf1(st[j][i]);
    const int c_begin = (sl == 0) ? -1 : 0;
    v4u pre[5]; float dtn = 0.f;
#define ROW_BASE(ci) ((ci) < 0 ? RS : b * SL + (ci) * 64)
#define SCAN_LOAD(ci) do { const int rb_ = ROW_BASE(ci); \
        _Pragma("unroll") for (int i_ = 0; i_ < 5; ++i_) { const int p_ = tid + 512 * i_, r_ = p_ / 40, pc_ = p_ % 40; const size_t gr_ = (size_t)(rb_ + r_); \
            const bf16* src_ = (pc_ < 8) ? (XS + gr_ * 2048 + h * 64 + pc_ * 8) : (pc_ < 24) ? (BMp + gr_ * 1024 + g * 128 + (pc_ - 8) * 8) : (CMp + gr_ * 1024 + g * 128 + (pc_ - 24) * 8); \
            pre[i_] = *(const v4u*)src_; } \
        if (wave == 0) dtn = DTp[(size_t)(rb_ + lane) * 32 + h]; } while (0)
#define SCAN_STORE_RAW() do { _Pragma("unroll") for (int i_ = 0; i_ < 5; ++i_) { const int p_ = tid + 512 * i_, r_ = p_ / 40, pc_ = p_ % 40; \
            *(LAS v4u*)(RAW + (3 + r_) * SC_RAWS + pc_ * 8) = pre[i_]; } } while (0)
#define SCAN_DT(par) do { if (wave == 0) { const float x_ = dtn + dtb; const float dv_ = (x_ > 20.f) ? x_ : log1pf(__expf(x_)); float a_ = aneg * dv_; \
            _Pragma("unroll") for (int o_ = 1; o_ < 64; o_ <<= 1) { const float t_ = __shfl_up(a_, o_); if (lane >= o_) a_ += t_; } \
            ACUM[(par) * 64 + lane] = a_; DTV[(par) * 64 + lane] = dv_; } } while (0)
    SCAN_LOAD(c_begin);
    SCAN_STORE_RAW();
    SCAN_DT(0);
    __syncthreads();
    int par = 0;
    for (int ci = c_begin; ci < SL / 64; ++ci, par ^= 1) {
        const bool has_next = (ci + 1 < SL / 64);
        const int lmask = (ci < 0) ? 48 : 0;
        const LAS float* AC = ACUM + par * 64; const LAS float* DV = DTV + par * 64;
        const float aend = AC[63];
        {
            float r[11];
#pragma unroll
            for (int i = 0; i < 11; ++i) r[i] = bf2f(RAW[(rbx * 8 + i) * SC_RAWS + chx]);
            float xv[8], xd[8], xe[8];
#pragma unroll
            for (int j = 0; j < 8; ++j) { const int l = rbx * 8 + j; float a = bx + wx[0] * r[j] + wx[1] * r[j + 1] + wx[2] * r[j + 2] + wx[3] * r[j + 3];
                a = (l >= lmask) ? siluf(a) : 0.f; xv[j] = a; xd[j] = a * DV[l]; xe[j] = xd[j] * __expf(aend - AC[l]); }
            v4u o;
            o.x = pk2(xv[0], xv[1]); o.y = pk2(xv[2], xv[3]); o.z = pk2(xv[4], xv[5]); o.w = pk2(xv[6], xv[7]); *(LAS v4u*)(XST + chx * SC_S64 + rbx * 8) = o;
            o.x = pk2(xd[0], xd[1]); o.y = pk2(xd[2], xd[3]); o.z = pk2(xd[4], xd[5]); o.w = pk2(xd[6], xd[7]); *(LAS v4u*)(XDTT + chx * SC_S64 + rbx * 8) = o;
            o.x = pk2(xe[0], xe[1]); o.y = pk2(xe[2], xe[3]); o.z = pk2(xe[4], xe[5]); o.w = pk2(xe[6], xe[7]); *(LAS v4u*)(XDTET + chx * SC_S64 + rbx * 8) = o;
        }
        __builtin_amdgcn_sched_barrier(0);
        {
            float r[19];
#pragma unroll
            for (int i = 0; i < 19; ++i) r[i] = bf2f(RAW[(rbb * 16 + i) * SC_RAWS + 64 + chb]);
            float v[16];
#pragma unroll
            for (int j = 0; j < 16; ++j) { const int l = rbb * 16 + j; float a = bB + wB[0] * r[j] + wB[1] * r[j + 1] + wB[2] * r[j + 2] + wB[3] * r[j + 3];
                a = (l >= lmask) ? siluf(a) : 0.f; v[j] = a; BC[l * SC_S128 + chb] = f2bf1(a); }
            v4u o;
            o.x = pk2(v[0], v[1]); o.y = pk2(v[2], v[3]); o.z = pk2(v[4], v[5]); o.w = pk2(v[6], v[7]); *(LAS v4u*)(BCT + chb * SC_S64 + rbb * 16) = o;
            o.x = pk2(v[8], v[9]); o.y = pk2(v[10], v[11]); o.z = pk2(v[12], v[13]); o.w = pk2(v[14], v[15]); *(LAS v4u*)(BCT + chb * SC_S64 + rbb * 16 + 8) = o;
        }
        __builtin_amdgcn_sched_barrier(0);
        {
            float r[19];
#pragma unroll
            for (int i = 0; i < 19; ++i) r[i] = bf2f(RAW[(rbb * 16 + i) * SC_RAWS + 192 + chb]);
#pragma unroll
            for (int j = 0; j < 16; ++j) { const int l = rbb * 16 + j; float a = bC + wC[0] * r[j] + wC[1] * r[j + 1] + wC[2] * r[j + 2] + wC[3] * r[j + 3];
                a = (l >= lmask) ? siluf(a) : 0.f; CC[l * SC_S128 + chb] = f2bf1(a); }
        }
        __syncthreads();
        if (has_next) SCAN_LOAD(ci + 1);
        if (tid < 123) { const v4u t = *(LAS v4u*)((LAS unsigned char*)RAW + 64 * SC_RAWS * 2 + tid * 16); *(LAS v4u*)((LAS unsigned char*)RAW + tid * 16) = t; }
        bf16x8 ca[4];
#pragma unroll
        for (int kk = 0; kk < 4; ++kk) ca[kk] = *(LAS bf16x8*)(CC + (tr * 16 + fr) * SC_S128 + kk * 32 + fq * 8);
        f32x4 yacc[2];
#pragma unroll
        for (int t = 0; t < 2; ++t) {
            const int tc = tc0 + t;
            f32x4 a1 = {0.f, 0.f, 0.f, 0.f}, a2 = {0.f, 0.f, 0.f, 0.f};
#pragma unroll
            for (int kk = 0; kk < 4; ++kk) {
                const bf16x8 bb = *(LAS bf16x8*)(BC + (tc * 16 + fr) * SC_S128 + kk * 32 + fq * 8);
                const bf16x8 sb = *(LAS bf16x8*)(STB + (tc * 16 + fr) * SC_S128 + kk * 32 + fq * 8);
                a1 = __builtin_amdgcn_mfma_f32_16x16x32_bf16(ca[kk], bb, a1, 0, 0, 0);
                a2 = __builtin_amdgcn_mfma_f32_16x16x32_bf16(ca[kk], sb, a2, 0, 0, 0);
            }
            const int s = tc * 16 + fr; const float as = AC[s];
#pragma unroll
            for (int i = 0; i < 4; ++i) { const int l = tr * 16 + fq * 4 + i; const float al = AC[l];
                const float mv = (l >= s) ? a1[i] * __expf(al - as) : 0.f;
                Mm[l * SC_S64 + s] = f2bf1(mv);
                yacc[t][i] = a2[i] * __expf(al); }
        }
        {
            const float dec = __expf(aend);
            bf16x8 xa[2];
#pragma unroll
            for (int kk = 0; kk < 2; ++kk) xa[kk] = *(LAS bf16x8*)(XDTET + (tp * 16 + fr) * SC_S64 + kk * 32 + fq * 8);
#pragma unroll
            for (int j = 0; j < 4; ++j) { st[j] = st[j] * dec;
#pragma unroll
                for (int kk = 0; kk < 2; ++kk) { const bf16x8 bb = *(LAS bf16x8*)(BCT + ((tn0 + j) * 16 + fr) * SC_S64 + kk * 32 + fq * 8);
                    st[j] = __builtin_amdgcn_mfma_f32_16x16x32_bf16(xa[kk], bb, st[j], 0, 0, 0); } }
        }
        __syncthreads();
#pragma unroll
        for (int j = 0; j < 4; ++j)
#pragma unroll
            for (int i = 0; i < 4; ++i) STB[(tp * 16 + fq * 4 + i) * SC_S128 + (tn0 + j) * 16 + fr] = f2bf1(st[j][i]);
        {
            bf16x8 ma[2];
#pragma unroll
            for (int kk = 0; kk < 2; ++kk) ma[kk] = *(LAS bf16x8*)(Mm + (tr * 16 + fr) * SC_S64 + kk * 32 + fq * 8);
            const int rb0 = ROW_BASE(ci);
#pragma unroll
            for (int t = 0; t < 2; ++t) { const int p = (tc0 + t) * 16 + fr;
#pragma unroll
                for (int kk = 0; kk < 2; ++kk) { const bf16x8 xb = *(LAS bf16x8*)(XDTT + p * SC_S64 + kk * 32 + fq * 8);
                    yacc[t] = __builtin_amdgcn_mfma_f32_16x16x32_bf16(ma[kk], xb, yacc[t], 0, 0, 0); }
                if (ci >= 0) {
#pragma unroll
                    for (int i = 0; i < 4; ++i) { const int l = tr * 16 + fq * 4 + i; const float yv = yacc[t][i] + dsk * bf2f(XST[p * SC_S64 + l]);
                        XS[(size_t)(rb0 + l) * 2048 + h * 64 + p] = f2bf1(yv); }
                }
            }
        }
        if (has_next) { SCAN_STORE_RAW(); SCAN_DT(par ^ 1); }
        __syncthreads();
    }
    if (sl + 1 < NSLICE) {
#pragma unroll
        for (int j = 0; j < 4; ++j)
#pragma unroll
            for (int i = 0; i < 4; ++i) STATE[(tp * 16 + fq * 4 + i) * 128 + (tn0 + j) * 16 + fr] = st[j][i];
        for (int i = tid; i < 3 * 320; i += 512) HALO[i] = RAW[(i / 320) * SC_RAWS + (i % 320)];
    }
#undef SCAN_LOAD
#undef ROW_BASE
#undef SCAN_STORE_RAW
#undef SCAN_DT
}

__device__ __forceinline__ void phase_elem(Ctx& C, const Args& A, int sl) {
    const int gw = C.vcu * NWAVES + C.wave, lane = opq(C.tid) & 63;
    unsigned char* ws = opq_p(C.ws);
    bf16* XS = (bf16*)(ws + WS_XS); const bf16* Zb = (const bf16*)(ws + WS_Z);
    {
        const float* ng = GIN(A, I_NORM);
        f32x4 gq[4][2];
#pragma unroll
        for (int j = 0; j < 4; ++j) { gq[j][0] = *(const f32x4*)(ng + 8 * lane + 512 * j); gq[j][1] = *(const f32x4*)(ng + 8 * lane + 512 * j + 4); }
        for (int rr = 0; rr < 8; ++rr) {
            const size_t r = (size_t)gw * 8 + rr;
            v4u yv[4], zv[4];
#pragma unroll
            for (int j = 0; j < 4; ++j) { yv[j] = *(const v4u*)(XS + r * 2048 + 8 * lane + 512 * j); zv[j] = *(const v4u*)(Zb + r * 2048 + 8 * lane + 512 * j); }
#pragma unroll
            for (int j = 0; j < 4; ++j) {
                float v[8];
#pragma unroll
                for (int q = 0; q < 4; ++q) { v[2 * q] = blo(yv[j][q]) * siluf(blo(zv[j][q])); v[2 * q + 1] = bhi(yv[j][q]) * siluf(bhi(zv[j][q])); }
                float ss = 0.f;
#pragma unroll
                for (int q = 0; q < 8; ++q) ss += v[q] * v[q];
#pragma unroll
                for (int o = 1; o < 32; o <<= 1) ss += __shfl_xor(ss, o);
                const float rs = rsqrtf(ss * (1.f / 256.f) + EPS);
                v4u o4; o4.x = pk2(v[0] * rs * gq[j][0][0], v[1] * rs * gq[j][0][1]); o4.y = pk2(v[2] * rs * gq[j][0][2], v[3] * rs * gq[j][0][3]);
                o4.z = pk2(v[4] * rs * gq[j][1][0], v[5] * rs * gq[j][1][1]); o4.w = pk2(v[6] * rs * gq[j][1][2], v[7] * rs * gq[j][1][3]);
                *(v4u*)(XS + r * 2048 + 8 * lane + 512 * j) = o4;
            }
        }
    }
    {
        const bf16* SBp = (const bf16*)(ws + WS_SB); const bf16* SCp = (const bf16*)(ws + WS_SC); const bf16* SXp = (const bf16*)(ws + WS_SX);
        bf16* SCV = (bf16*)(ws + WS_U0); float* SCH = (float*)(ws + WS_SCH);
        const float* w3 = GIN(A, I_SCCW);
        const int r0 = gw * 8, b = r0 >> 11, s0 = r0 & (SL - 1);
#pragma unroll
        for (int j = 0; j < 2; ++j) {
            const int ch0 = 8 * lane + 512 * j;
            float w0[8], w1[8], w2[8];
#pragma unroll
            for (int q = 0; q < 8; ++q) { w0[q] = w3[(ch0 + q) * 3 + 0]; w1[q] = w3[(ch0 + q) * 3 + 1]; w2[q] = w3[(ch0 + q) * 3 + 2]; }
            float pm2[8], pm1[8];
            if (s0 == 0 && sl > 0) {
#pragma unroll
                for (int q = 0; q < 8; ++q) { pm2[q] = SCH[(b * 2 + 0) * 1024 + ch0 + q]; pm1[q] = SCH[(b * 2 + 1) * 1024 + ch0 + q]; }
            } else {
                const size_t ra = (s0 == 0) ? (size_t)(RS + 62) : (size_t)(r0 - 2), rb = (s0 == 0) ? (size_t)(RS + 63) : (size_t)(r0 - 1);
                const v4u c2 = *(const v4u*)(SCp + ra * 1024 + ch0), x2 = *(const v4u*)(SXp + ra * 1024 + ch0), c1 = *(const v4u*)(SCp + rb * 1024 + ch0), x1 = *(const v4u*)(SXp + rb * 1024 + ch0);
#pragma unroll
                for (int q = 0; q < 4; ++q) { pm2[2 * q] = blo(c2[q]) * blo(x2[q]); pm2[2 * q + 1] = bhi(c2[q]) * bhi(x2[q]); pm1[2 * q] = blo(c1[q]) * blo(x1[q]); pm1[2 * q + 1] = bhi(c1[q]) * bhi(x1[q]); }
            }
            for (int rr = 0; rr < 8; ++rr) {
                const size_t r = (size_t)r0 + rr;
                const v4u cv = *(const v4u*)(SCp + r * 1024 + ch0), xv = *(const v4u*)(SXp + r * 1024 + ch0), bv = *(const v4u*)(SBp + r * 1024 + ch0);
                float p0[8], o[8];
#pragma unroll
                for (int q = 0; q < 4; ++q) { p0[2 * q] = blo(cv[q]) * blo(xv[q]); p0[2 * q + 1] = bhi(cv[q]) * bhi(xv[q]); }
#pragma unroll
                for (int q = 0; q < 4; ++q) { o[2 * q] = blo(bv[q]) * (w0[2 * q] * pm2[2 * q] + w1[2 * q] * pm1[2 * q] + w2[2 * q] * p0[2 * q]);
                    o[2 * q + 1] = bhi(bv[q]) * (w0[2 * q + 1] * pm2[2 * q + 1] + w1[2 * q + 1] * pm1[2 * q + 1] + w2[2 * q + 1] * p0[2 * q + 1]); }
                v4u o4; o4.x = pk2(o[0], o[1]); o4.y = pk2(o[2], o[3]); o4.z = pk2(o[4], o[5]); o4.w = pk2(o[6], o[7]);
                *(v4u*)(SCV + r * 1024 + ch0) = o4;
#pragma unroll
                for (int q = 0; q < 8; ++q) { pm2[q] = pm1[q]; pm1[q] = p0[q]; }
            }
            if (sl + 1 < NSLICE && s0 == SL - 8) {
#pragma unroll
                for (int q = 0; q < 8; ++q) { SCH[(b * 2 + 0) * 1024 + ch0 + q] = pm2[q]; SCH[(b * 2 + 1) * 1024 + ch0 + q] = pm1[q]; }
            }
        }
    }
}

__device__ __forceinline__ void phase_norm(Ctx& C, const Args& A, int sl) {
    const int gw = C.vcu * NWAVES + C.wave, NGW = C.G * NWAVES, lane = opq(C.tid) & 63;
    unsigned char* ws = opq_p(C.ws);
    const float* H1 = (const float*)(ws + WS_Z); bf16* U1 = (bf16*)(ws + WS_BM);
    for (int r = gw; r < RS; r += NGW) rms_row_bf16(H1 + (size_t)r * DM, GIN(A, I_LNFFN), U1 + (size_t)r * DM, lane);
    if (sl + 1 < NSLICE) for (int r = gw; r < RS; r += NGW) rms_row_bf16(u0_src(A, sl + 1, r), GIN(A, I_LNMIX), (bf16*)(ws + WS_U0) + (size_t)r * DM, lane);
}

__device__ __forceinline__ int med3i(int a, int b, int c) { int r; asm("v_med3_i32 %0, %1, %2, %3" : "=v"(r) : "v"(a), "v"(b), "v"(c)); return r; }
__device__ __forceinline__ int ord_key(float f) { int k = __builtin_bit_cast(int, f); return k ^ ((k >> 31) & 0x7fffffff); }
__device__ __forceinline__ float ord_val(int k) { return __builtin_bit_cast(float, k ^ ((k >> 31) & 0x7fffffff)); }
#define TK_INSERT(L, x) do { const int x_ = (x); \
    L[15] = med3i(L[14], x_, L[15]); L[14] = med3i(L[13], x_, L[14]); L[13] = med3i(L[12], x_, L[13]); L[12] = med3i(L[11], x_, L[12]); \
    L[11] = med3i(L[10], x_, L[11]); L[10] = med3i(L[9], x_, L[10]); L[9] = med3i(L[8], x_, L[9]); L[8] = med3i(L[7], x_, L[8]); \
    L[7] = med3i(L[6], x_, L[7]); L[6] = med3i(L[5], x_, L[6]); L[5] = med3i(L[4], x_, L[5]); L[4] = med3i(L[3], x_, L[4]); \
    L[3] = med3i(L[2], x_, L[3]); L[2] = med3i(L[1], x_, L[2]); L[1] = med3i(L[0], x_, L[1]); L[0] = max(L[0], x_); } while (0)
constexpr int TK_QS = 136, TK_KS = 136;
constexpr int TK_SK_OFF = 0, TK_Q_OFF = 2 * 128 * TK_KS * 2;
static_assert(TK_Q_OFF + 8 * 32 * TK_QS * 2 <= MISC_OFF, "topk LDS map");

__device__ __forceinline__ void phase_topk(Ctx& C) {
    const int tid = opq(C.tid), lane = tid & 63, r32 = lane & 31, hf = lane >> 5;
    unsigned char* ws = opq_p(C.ws);
    const bf16* Q = (const bf16*)(ws + WS_GT); const bf16* SK = (const bf16*)(ws + WS_SK);
    int* EIDX = (int*)(ws + WS_SB); float* GWV = (float*)(ws + WS_SB + 8 * MiB); float* SUW = (float*)(ws + WS_SB + 16 * MiB);
    const float* SU = (const float*)(ws + WS_SU); const float* SV = (const float*)(ws + WS_SV);
    const int hh = C.vcu & 7, wg8 = C.vcu >> 3;
    LAS bf16* SKl = (LAS bf16*)(C.lds + TK_SK_OFF); LAS bf16* Qs = (LAS bf16*)(C.lds + TK_Q_OFF + C.wave * 32 * TK_QS * 2);
#pragma unroll
    for (int i = 0; i < 8; ++i) { const int piece = tid + 512 * i, row = piece >> 4, c16 = piece & 15;
        *(LAS v4u*)(SKl + row * TK_KS + c16 * 8) = *(const v4u*)(SK + (size_t)(hh * 256 + row) * 128 + c16 * 8); }
    __syncthreads();
    for (int it = 0; it < 2; ++it) {
        const int tb = wg8 * 16 + it * 8 + C.wave, r0 = tb * 32;
        int LA[16], LB[16];
#pragma unroll
        for (int j = 0; j < 2; ++j) {
#pragma unroll
            for (int i = 0; i < 8; ++i) { const int piece = i * 64 + lane, row = piece >> 4, c16 = piece & 15;
                *(LAS v4u*)(Qs + row * TK_QS + c16 * 8) = *(const v4u*)(Q + (size_t)(r0 + row) * 2048 + hh * 256 + j * 128 + c16 * 8); }
            LDS_WAIT(); asm volatile("" ::: "memory");
            f32x16 acc[4];
#pragma unroll
            for (int kb = 0; kb < 4; ++kb)
#pragma unroll
                for (int q = 0; q < 16; ++q) acc[kb][q] = 0.f;
#pragma unroll
            for (int kk = 0; kk < 8; ++kk) {
                const bf16x8 bq = *(LAS bf16x8*)(Qs + r32 * TK_QS + kk * 16 + hf * 8);
#pragma unroll
                for (int kb = 0; kb < 4; ++kb) { const bf16x8 ak = *(LAS bf16x8*)(SKl + (j * 128 + kb * 32 + r32) * TK_KS + kk * 16 + hf * 8);
                    acc[kb] = __builtin_amdgcn_mfma_f32_32x32x16_bf16(ak, bq, acc[kb], 0, 0, 0); }
            }
            LDS_WAIT(); asm volatile("" ::: "memory");
            int L[16];
#pragma unroll
            for (int q = 0; q < 16; ++q) L[q] = (int)0x80000000;
#pragma unroll
            for (int kb = 0; kb < 4; ++kb)
#pragma unroll
                for (int q = 0; q < 16; ++q) { const int key = kb * 32 + (q & 3) + 8 * (q >> 2) + 4 * hf;
                    const int x = (ord_key(acc[kb][q]) & ~127) | (127 - key); TK_INSERT(L, x); }
            int T[16];
#pragma unroll
            for (int q = 0; q < 16; ++q) T[q] = __shfl_xor(L[q], 32);
#pragma unroll
            for (int q = 0; q < 16; ++q) TK_INSERT(L, T[q]);
            if (j == 0) {
#pragma unroll
                for (int q = 0; q < 16; ++q) LA[q] = L[q];
            } else {
#pragma unroll
                for (int q = 0; q < 16; ++q) LB[q] = L[q];
            }
        }
        float av[16], bv[16]; unsigned pa[4] = {0u, 0u, 0u, 0u}, pb[4] = {0u, 0u, 0u, 0u};
#pragma unroll
        for (int q = 0; q < 16; ++q) { av[q] = ord_val(LA[q] & ~127); bv[q] = ord_val(LB[q] & ~127);
            pa[q >> 2] |= (unsigned)(127 - (LA[q] & 127)) << (8 * (q & 3)); pb[q >> 2] |= (unsigned)(127 - (LB[q] & 127)) << (8 * (q & 3)); }
        int LC[16];
#pragma unroll
        for (int q = 0; q < 16; ++q) LC[q] = (int)0x80000000;
#pragma unroll
        for (int i = 0; i < 16; ++i)
#pragma unroll
            for (int jj = 0; jj < 16; ++jj)
                if ((i + 1) * (jj + 1) <= 16) { const int x = (ord_key(av[i] + bv[jj]) & ~255) | (255 - (i * 16 + jj)); TK_INSERT(LC, x); }
        float cs[16], es[16], esum = 0.f; int ei[16];
#pragma unroll
        for (int q = 0; q < 16; ++q) { cs[q] = ord_val(LC[q] & ~255); const int ci = 255 - (LC[q] & 255), i = ci >> 4, jj = ci & 15;
            const unsigned wa = (i < 8) ? ((i < 4) ? pa[0] : pa[1]) : ((i < 12) ? pa[2] : pa[3]);
            const unsigned wb = (jj < 8) ? ((jj < 4) ? pb[0] : pb[1]) : ((jj < 12) ? pb[2] : pb[3]);
            const int i1 = (wa >> (8 * (i & 3))) & 255, i2 = (wb >> (8 * (jj & 3))) & 255;
            ei[q] = i1 * 128 + i2; }
#pragma unroll
        for (int q = 0; q < 16; ++q) { es[q] = __expf(cs[q] - cs[0]); esum += es[q]; }
        const float rinv = 1.0f / esum;
        if (hf == 0) {
            int* ep = EIDX + (size_t)(r0 + r32) * 128 + hh * 16; float* gp = GWV + (size_t)(r0 + r32) * 128 + hh * 16; float* sp = SUW + (size_t)(r0 + r32) * 128 + hh * 16;
            float su_[16], sv_[16];
#pragma unroll
            for (int q = 0; q < 16; ++q) { su_[q] = SU[ei[q]]; sv_[q] = SV[ei[q]]; }
#pragma unroll
            for (int q = 0; q < 4; ++q) { *(int4*)(ep + 4 * q) = make_int4(ei[4 * q], ei[4 * q + 1], ei[4 * q + 2], ei[4 * q + 3]);
                *(f32x4*)(gp + 4 * q) = (f32x4){es[4 * q] * rinv * sv_[4 * q], es[4 * q + 1] * rinv * sv_[4 * q + 1], es[4 * q + 2] * rinv * sv_[4 * q + 2], es[4 * q + 3] * rinv * sv_[4 * q + 3]};
                *(f32x4*)(sp + 4 * q) = (f32x4){su_[4 * q], su_[4 * q + 1], su_[4 * q + 2], su_[4 * q + 3]}; }
        }
    }
}

typedef float f32x2v __attribute__((ext_vector_type(2)));
__device__ __forceinline__ void fp8x16_to_f32(const v4u r, float (&f)[16]) {
#pragma unroll
    for (int q = 0; q < 4; ++q) { const f32x2v lo = __builtin_amdgcn_cvt_pk_f32_fp8((int)r[q], false), hi = __builtin_amdgcn_cvt_pk_f32_fp8((int)r[q], true);
        f[4 * q] = lo[0]; f[4 * q + 1] = lo[1]; f[4 * q + 2] = hi[0]; f[4 * q + 3] = hi[1]; }
}
__device__ __forceinline__ void fp8x16_to_f32x2(const v4u r, f32x2v (&f)[8]) {
#pragma unroll
    for (int q = 0; q < 4; ++q) { f[2 * q] = __builtin_amdgcn_cvt_pk_f32_fp8((int)r[q], false); f[2 * q + 1] = __builtin_amdgcn_cvt_pk_f32_fp8((int)r[q], true); }
}
__device__ __forceinline__ float gelu_erf(float x) { return 0.5f * x * (1.0f + erff(x * 0.70710678118654752f)); }

struct PeerStage { v4u rows[16]; float aux[16]; int t; };
__device__ __forceinline__ void lds_slots16(LAS int* El, int rg, int (&ee)[16]) {
    typedef int v4i_ __attribute__((ext_vector_type(4)));
#pragma unroll
    for (int q = 0; q < 4; ++q) { const v4i_ ev = *(LAS v4i_*)(El + rg * 16 + 4 * q); ee[4 * q] = ev[0]; ee[4 * q + 1] = ev[1]; ee[4 * q + 2] = ev[2]; ee[4 * q + 3] = ev[3]; }
}
struct DotsMeta { int e0, e1; v4u ua, ub; };
__device__ __forceinline__ void phase_peer_dots(Ctx& C) {
    const int lane = opq(C.tid) & 63, rg = lane >> 3, ck = lane & 7;
    const int x = C.vcu >> 5, wv = (C.vcu & 31) * NWAVES + C.wave;
    unsigned char* ws = opq_p(C.ws);
    const bf16* U1 = (const bf16*)(ws + WS_BM) + 128 * x + ck * 16; const int* EIDX = (const int*)(ws + WS_SB);
    float* PART = (float*)(ws + WS_XS) + (size_t)x * RS * 128;
    const unsigned char* EU8 = ws + WS_EU + (size_t)x * 16384 * 128 + ck * 16;
    LAS int* El = (LAS int*)(C.lds + C.wave * 1024);
#define DM_LOAD(M, tt) do { const int t_ = (tt) < RS ? (tt) : RS - 1; M.e0 = EIDX[(size_t)t_ * 128 + lane]; M.e1 = EIDX[(size_t)t_ * 128 + 64 + lane]; \
        M.ua = *(const v4u*)(U1 + (size_t)t_ * DM); M.ub = *(const v4u*)(U1 + (size_t)t_ * DM + 8); } while (0)
#define DM_STAGE(S, M, tt) do { S.t = (tt); El[lane] = M.e0; El[64 + lane] = M.e1; LDS_WAIT(); asm volatile("" ::: "memory"); int ee_[16]; lds_slots16(El, rg, ee_); \
        _Pragma("unroll") for (int i_ = 0; i_ < 16; ++i_) S.rows[i_] = *(const v4u*)(EU8 + (size_t)ee_[i_] * 128); \
        _Pragma("unroll") for (int q_ = 0; q_ < 4; ++q_) { S.aux[2 * q_] = blo(M.ua[q_]); S.aux[2 * q_ + 1] = bhi(M.ua[q_]); S.aux[8 + 2 * q_] = blo(M.ub[q_]); S.aux[8 + 2 * q_ + 1] = bhi(M.ub[q_]); } \
        LDS_WAIT(); asm volatile("" ::: "memory"); } while (0)
#define DM_COMPUTE(S) do { float p_[16]; \
        _Pragma("unroll") for (int i_ = 0; i_ < 16; ++i_) { f32x2v f_[8]; fp8x16_to_f32x2(S.rows[i_], f_); f32x2v s_ = {0.f, 0.f}; \
            _Pragma("unroll") for (int q_ = 0; q_ < 8; ++q_) { const f32x2v u_ = {S.aux[2 * q_], S.aux[2 * q_ + 1]}; s_ = f_[q_] * u_ + s_; } p_[i_] = s_[0] + s_[1]; } \
        float q8_[8], q4_[4], q2_[2]; \
        { const bool bt_ = lane & 1; _Pragma("unroll") for (int m_ = 0; m_ < 8; ++m_) { const float k_ = bt_ ? p_[2 * m_ + 1] : p_[2 * m_], s_ = bt_ ? p_[2 * m_] : p_[2 * m_ + 1]; q8_[m_] = k_ + __shfl_xor(s_, 1); } } \
        { const bool bt_ = lane & 2; _Pragma("unroll") for (int m_ = 0; m_ < 4; ++m_) { const float k_ = bt_ ? q8_[2 * m_ + 1] : q8_[2 * m_], s_ = bt_ ? q8_[2 * m_] : q8_[2 * m_ + 1]; q4_[m_] = k_ + __shfl_xor(s_, 2); } } \
        { const bool bt_ = lane & 4; _Pragma("unroll") for (int m_ = 0; m_ < 2; ++m_) { const float k_ = bt_ ? q4_[2 * m_ + 1] : q4_[2 * m_], s_ = bt_ ? q4_[2 * m_] : q4_[2 * m_ + 1]; q2_[m_] = k_ + __shfl_xor(s_, 4); } } \
        float* pp_ = PART + (size_t)S.t * 128 + rg * 16 + ck; pp_[0] = q2_[0]; pp_[8] = q2_[1]; } while (0)
    DotsMeta m0, m1; PeerStage sA, sB;
    DM_LOAD(m0, wv); DM_LOAD(m1, wv + 256); DM_STAGE(sA, m0, wv);
    for (int t = wv; t < RS; t += 512) {
        DM_LOAD(m0, t + 512); DM_STAGE(sB, m1, t + 256);
        DM_COMPUTE(sA);
        DM_LOAD(m1, t + 768); DM_STAGE(sA, m0, (t + 512 < RS) ? t + 512 : RS - 1);
        DM_COMPUTE(sB);
    }
#undef DM_LOAD
#undef DM_STAGE
#undef DM_COMPUTE
}
__device__ __forceinline__ void phase_peer_w(Ctx& C) {
    const int gw = C.vcu * NWAVES + C.wave, NGW = C.G * NWAVES, lane = opq(C.tid) & 63;
    unsigned char* ws = opq_p(C.ws);
    const float* PART = (const float*)(ws + WS_XS); const float* GWV = (const float*)(ws + WS_SB + 8 * MiB); const float* SUW = (const float*)(ws + WS_SB + 16 * MiB); float* W = (float*)(ws + WS_SB + 24 * MiB);
    for (int r = gw; r < RS / 2; r += NGW) {
        const size_t o = (size_t)(2 * r) * 128 + 4 * lane;
        f32x4 s = *(const f32x4*)(PART + o);
#pragma unroll
        for (int xx = 1; xx < 8; ++xx) s += *(const f32x4*)(PART + (size_t)xx * RS * 128 + o);
        const f32x4 su = *(const f32x4*)(SUW + o), gv = *(const f32x4*)(GWV + o);
        f32x4 w;
#pragma unroll
        for (int q = 0; q < 4; ++q) w[q] = gv[q] * gelu_erf(s[q] * su[q]);
        *(f32x4*)(W + o) = w;
    }
}
struct OutMeta { int e0, e1; float w0, w1; };
__device__ __forceinline__ void phase_peer_out(Ctx& C) {
    const int lane = opq(C.tid) & 63, rg = lane >> 3, ck = lane & 7;
    const int x = C.vcu >> 5, wv = (C.vcu & 31) * NWAVES + C.wave;
    unsigned char* ws = opq_p(C.ws);
    const int* EIDX = (const int*)(ws + WS_SB); const float* W = (const float*)(ws + WS_SB + 24 * MiB);
    float* FF = (float*)(ws + WS_XS) + 128 * x + ck * 16 + rg;
    const unsigned char* EV8 = ws + WS_EV + (size_t)x * 16384 * 128 + ck * 16;
    LAS int* El = (LAS int*)(C.lds + C.wave * 1024); LAS float* Wl = (LAS float*)(C.lds + C.wave * 1024 + 512);
#define OM_LOAD(M, tt) do { const int t_ = (tt) < RS ? (tt) : RS - 1; M.e0 = EIDX[(size_t)t_ * 128 + lane]; M.e1 = EIDX[(size_t)t_ * 128 + 64 + lane]; \
        M.w0 = W[(size_t)t_ * 128 + lane]; M.w1 = W[(size_t)t_ * 128 + 64 + lane]; } while (0)
#define OM_STAGE(S, M, tt) do { S.t = (tt); El[lane] = M.e0; El[64 + lane] = M.e1; Wl[lane] = M.w0; Wl[64 + lane] = M.w1; LDS_WAIT(); asm volatile("" ::: "memory"); int ee_[16]; lds_slots16(El, rg, ee_); \
        _Pragma("unroll") for (int i_ = 0; i_ < 16; ++i_) S.rows[i_] = *(const v4u*)(EV8 + (size_t)ee_[i_] * 128); \
        _Pragma("unroll") for (int q_ = 0; q_ < 4; ++q_) { const f32x4 w4_ = *(LAS f32x4*)(Wl + rg * 16 + 4 * q_); S.aux[4 * q_] = w4_[0]; S.aux[4 * q_ + 1] = w4_[1]; S.aux[4 * q_ + 2] = w4_[2]; S.aux[4 * q_ + 3] = w4_[3]; } \
        LDS_WAIT(); asm volatile("" ::: "memory"); } while (0)
#define OM_COMPUTE(S) do { f32x2v a2_[8]; \
        _Pragma("unroll") for (int q_ = 0; q_ < 8; ++q_) a2_[q_] = (f32x2v){0.f, 0.f}; \
        _Pragma("unroll") for (int i_ = 0; i_ < 16; ++i_) { f32x2v f_[8]; fp8x16_to_f32x2(S.rows[i_], f_); const f32x2v w_ = {S.aux[i_], S.aux[i_]}; \
            _Pragma("unroll") for (int q_ = 0; q_ < 8; ++q_) a2_[q_] = f_[q_] * w_ + a2_[q_]; } \
        float acc_[16]; _Pragma("unroll") for (int q_ = 0; q_ < 8; ++q_) { acc_[2 * q_] = a2_[q_][0]; acc_[2 * q_ + 1] = a2_[q_][1]; } \
        float q8_[8], q4_[4], q2_[2]; \
        { const bool bt_ = lane & 8; _Pragma("unroll") for (int m_ = 0; m_ < 8; ++m_) { const float k_ = bt_ ? acc_[2 * m_ + 1] : acc_[2 * m_], s_ = bt_ ? acc_[2 * m_] : acc_[2 * m_ + 1]; q8_[m_] = k_ + __shfl_xor(s_, 8); } } \
        { const bool bt_ = lane & 16; _Pragma("unroll") for (int m_ = 0; m_ < 4; ++m_) { const float k_ = bt_ ? q8_[2 * m_ + 1] : q8_[2 * m_], s_ = bt_ ? q8_[2 * m_] : q8_[2 * m_ + 1]; q4_[m_] = k_ + __shfl_xor(s_, 16); } } \
        { const bool bt_ = lane & 32; _Pragma("unroll") for (int m_ = 0; m_ < 2; ++m_) { const float k_ = bt_ ? q4_[2 * m_ + 1] : q4_[2 * m_], s_ = bt_ ? q4_[2 * m_] : q4_[2 * m_ + 1]; q2_[m_] = k_ + __shfl_xor(s_, 32); } } \
        float* fp_ = FF + (size_t)S.t * DM; fp_[0] = q2_[0]; fp_[8] = q2_[1]; } while (0)
    OutMeta m0, m1; PeerStage sA, sB;
    OM_LOAD(m0, wv); OM_LOAD(m1, wv + 256); OM_STAGE(sA, m0, wv);
    for (int t = wv; t < RS; t += 512) {
        OM_LOAD(m0, t + 512); OM_STAGE(sB, m1, t + 256);
        OM_COMPUTE(sA);
        OM_LOAD(m1, t + 768); OM_STAGE(sA, m0, (t + 512 < RS) ? t + 512 : RS - 1);
        OM_COMPUTE(sB);
    }
#undef OM_LOAD
#undef OM_STAGE
#undef OM_COMPUTE
}

__device__ __forceinline__ void phase_final(Ctx& C, const Args& A, int sl) {
    const int gw = C.vcu * NWAVES + C.wave, NGW = C.G * NWAVES, lane = opq(C.tid) & 63;
    unsigned char* ws = opq_p(C.ws);
    const float* H1 = (const float*)(ws + WS_Z); const float* FF = (const float*)(ws + WS_XS);
    const f32x4* gr = (const f32x4*)GIN(A, I_LNF) + lane;
    for (int r = gw; r < RS; r += NGW) {
        const f32x4* hp = (const f32x4*)(H1 + (size_t)r * DM) + lane; const f32x4* fp = (const f32x4*)(FF + (size_t)r * DM) + lane;
        f32x4 v[4]; float s = 0.f;
#pragma unroll
        for (int j = 0; j < 4; ++j) { v[j] = hp[64 * j] + fp[64 * j]; s += (v[j][0] * v[j][0] + v[j][1] * v[j][1]) + (v[j][2] * v[j][2] + v[j][3] * v[j][3]); }
        const float rs = rsqrtf(wave_sum(s) * (1.f / 1024.f) + EPS);
        f32x4* op = (f32x4*)((float*)(GAS float*)A.out + ((size_t)(r >> 11) * SEQ + sl * SL + (r & (SL - 1))) * DM) + lane;
#pragma unroll
        for (int j = 0; j < 4; ++j) op[64 * j] = v[j] * rs * gr[64 * j];
    }
}

#ifndef MK_PER_PHASE
#define MK_PER_PHASE 0
#endif
constexpr int PH_PER_SLICE = 13, N_PHASES = 1 + NSLICE * PH_PER_SLICE;

__global__ void __launch_bounds__(NWAVES * 64, 2) mk_fwd(Args args) {
    extern __shared__ __attribute__((aligned(16))) unsigned char lds_[];
    Ctx C;
    C.lds = (LAS unsigned char*)lds_;
    C.tid = threadIdx.x; C.lane = C.tid & 63; C.wave = __builtin_amdgcn_readfirstlane(C.tid >> 6);
    C.G = gridDim.x; { const int bx = blockIdx.x; C.vcu = (C.G % 8 == 0) ? (bx % 8) * (C.G / 8) + bx / 8 : bx; }
    C.out = args.out; C.ws = args.ws;
    unsigned char* ws = (unsigned char*)(GAS unsigned char*)args.ws;
    volatile LAS unsigned* MISC = (volatile LAS unsigned*)(C.lds + MISC_OFF);
    if (C.tid < 64) MISC[C.tid] = 0u;
    __syncthreads();
    unsigned* barw = (unsigned*)(ws + WS_CTL) + CW_BAR;
    XcdBarrier bar; bar.bar = barw; bar.x = 0; bar.st = nullptr;
    const int lo = args.ph_lo, hi = args.ph_hi;
    if (hi - lo > 1) bar = xcd_barrier_post(barw, MISC + 8);
#define SEAM(id) do { if ((id) + 1 < hi) xcd_barrier(bar); } while (0)
#ifndef ONLY
#define ONLY -1
#endif
#define KIND(k) (ONLY < 0 || ONLY == (k))
#define IN(id) (lo <= (id) && (id) < hi)

    if (KIND(0) && IN(0)) { phase_prep(C, args); SEAM(0); }
    for (int sl = 0; sl < NSLICE; ++sl) {
        const int base = 1 + sl * PH_PER_SLICE;
        ws = opq_p(ws);
        if (KIND(1) && IN(base + 0)) {
            const int Mrows = (sl == 0) ? RP : RS;
            pg8::Gemm g{(const bf16*)(ws + WS_U0), (const bf16*)(ws + WS_WIN), Mrows, NPROJ, DM}; pg8::StaticOrder S; S.init(Mrows, NPROJ, C.G, (int)blockIdx.x);
            pg8::EpiProj E{(bf16*)(ws + WS_Z), (bf16*)(ws + WS_XS), (bf16*)(ws + WS_BM), (bf16*)(ws + WS_CM), (bf16*)(ws + WS_SB), (bf16*)(ws + WS_SC), (bf16*)(ws + WS_SX), (bf16*)(ws + WS_GT), (float*)(ws + WS_DT)};
            pg8::gemm_phase<pg8::EpiProj, pg8::StaticOrder, true, true>(C.lds, g, S, E);
            SEAM(base + 0);
        }
        if (KIND(2) && IN(base + 1)) { phase_scan(C, args, sl); SEAM(base + 1); }
        if (KIND(3) && IN(base + 2)) { phase_elem(C, args, sl); SEAM(base + 2); }
        if (KIND(4) && IN(base + 3)) {
            pg8::Gemm g{(const bf16*)(ws + WS_XS), (const bf16*)(ws + WS_WSSD), RS, DM, 2048}; pg8::StaticOrder S; S.init(RS, DM, C.G, (int)blockIdx.x);
            pg8::EpiF32Plain E{(float*)(ws + WS_BM), DM};
            pg8::gemm_phase<pg8::EpiF32Plain, pg8::StaticOrder, true, true>(C.lds, g, S, E);
            SEAM(base + 3);
        }
        if (KIND(5) && IN(base + 4)) {
            pg8::Gemm g{(const bf16*)(ws + WS_U0), (const bf16*)(ws + WS_WSC), RS, DM, DM}; pg8::StaticOrder S; S.init(RS, DM, C.G, (int)blockIdx.x);
            pg8::EpiMerge E{(const float*)(ws + WS_BM), (const bf16*)(ws + WS_GT), (bf16*)(ws + WS_SX)};
            pg8::gemm_phase<pg8::EpiMerge, pg8::StaticOrder, true, true>(C.lds, g, S, E);
            SEAM(base + 4);
        }
        if (KIND(6) && IN(base + 5)) {
            pg8::Gemm g{(const bf16*)(ws + WS_SX), (const bf16*)(ws + WS_WO), RS, DM, DM}; pg8::StaticOrder S; S.init(RS, DM, C.G, (int)blockIdx.x);
            pg8::EpiWo E{GIN(args, I_X), (float*)(ws + WS_Z), sl * SL};
            pg8::gemm_phase<pg8::EpiWo, pg8::StaticOrder, true, true>(C.lds, g, S, E);
            SEAM(base + 5);
        }
        if (KIND(7) && IN(base + 6)) { phase_norm(C, args, sl); SEAM(base + 6); }
        if (KIND(8) && IN(base + 7)) {
            pg8::Gemm g{(const bf16*)(ws + WS_BM), (const bf16*)(ws + WS_WQ), RS, 2048, DM}; pg8::StaticOrder S; S.init(RS, 2048, C.G, (int)blockIdx.x);
            pg8::EpiBf16Plain E{(bf16*)(ws + WS_GT), 2048};
            pg8::gemm_phase<pg8::EpiBf16Plain, pg8::StaticOrder, true, true>(C.lds, g, S, E);
            SEAM(base + 7);
        }
        if (KIND(9) && IN(base + 8)) { phase_topk(C); SEAM(base + 8); }
        if (KIND(10) && IN(base + 9)) { phase_peer_dots(C); SEAM(base + 9); }
        if (KIND(13) && IN(base + 10)) { phase_peer_w(C); SEAM(base + 10); }
        if (KIND(11) && IN(base + 11)) { phase_peer_out(C); SEAM(base + 11); }
        if (KIND(12) && IN(base + 12)) { phase_final(C, args, sl); SEAM(base + 12); }
    }
#undef SEAM
#undef IN
}

extern "C" void kernel_launch(void* const* d_in, const int* in_sizes, int n_in, void* d_out, int out_size, void* d_ws, size_t ws_size, hipStream_t stream) {
    static int ready = 0;
    if (ready == 0) {
        if (n_in != 20 || ws_size < WS_END) { fprintf(stderr, "kernel_launch: unexpected inputs (n_in %d, ws %zu)\n", n_in, ws_size); ready = -1; return; }
        if (hipFuncSetAttribute((const void*)mk_fwd, hipFuncAttributeMaxDynamicSharedMemorySize, LDS_BYTES) != hipSuccess) { fprintf(stderr, "kernel_launch: hipFuncSetAttribute failed\n"); ready = -1; return; }
        ready = 1;
    }
    if (ready < 0) return;
    (void)hipMemsetAsync((char*)d_ws + WS_CTL, 0, CTL_ZERO_BYTES, stream);
    Args a{};
    for (int i = 0; i < 20; ++i) a.in[i] = (const float*)d_in[i];
    a.out = (float*)d_out; a.ws = (unsigned char*)d_ws;
    const int grid = 256;
#if MK_PER_PHASE
    for (int p = 0; p < N_PHASES; ++p) { a.ph_lo = p; a.ph_hi = p + 1; hipLaunchKernelGGL(mk_fwd, dim3(grid), dim3(NWAVES * 64), LDS_BYTES, stream, a); }
#else
    a.ph_lo = 0; a.ph_hi = N_PHASES;
    hipLaunchKernelGGL(mk_fwd, dim3(grid), dim3(NWAVES * 64), LDS_BYTES, stream, a);
#endif
}
```
